# Optimizing an MI355X kernel written in HIP

```python
import math
import jax, jax.numpy as jnp
from jax import lax
import numpy as np

D_MODEL = 2048
BATCH = 4
SEQ = 4096
DEPTH = 4

N_A = DEPTH // 2
N_B = DEPTH - N_A
MEM_LEN = 256
RET_HEADS = 8
RET_DK = D_MODEL // 16
RET_DV = 2 * RET_DK
RET_CHUNK = 128
RET_THETA_BASE = 10000.0
DIL_CONFIG = ((128, 1), (512, 4), (2048, 16))
DIL_HEADS = 16
DIL_DH = D_MODEL // 16
DIL_BLOCK = 128
MEM_HEADS = 4
MEM_DH = D_MODEL // 8
EPS = 1e-6

RET_QK_W = RET_HEADS * RET_DK
RET_V_W = RET_HEADS * RET_DV
DIL_W = DIL_HEADS * DIL_DH
MEM_W = MEM_HEADS * MEM_DH
MIX_W_A = RET_V_W + MEM_W
MIX_W_B = DIL_W + MEM_W
IN_W_A = 2 * RET_QK_W + 2 * RET_V_W + 2 * MEM_W
IN_W_B = len(DIL_CONFIG) * DIL_W + DIL_W + 2 * MEM_W
KV_W = 2 * len(DIL_CONFIG) * DIL_W

kernel_name = "yoco_retention_dilated_hybrid"


def split_cols(a, widths):
    idx, acc = [], 0
    for w in widths[:-1]:
        acc += w
        idx.append(acc)
    return jnp.split(a, idx, axis=-1)


def rmsnorm(x, g):
    xf = x.astype(jnp.float32)
    y = xf * lax.rsqrt(jnp.mean(xf * xf, axis=-1, keepdims=True) + EPS) * g.astype(jnp.float32)
    return y.astype(x.dtype)


def rotary(t):
    S, half = t.shape[1], t.shape[-1] // 2
    inv = 1.0 / (RET_THETA_BASE ** jnp.linspace(0.0, 1.0, half, dtype=jnp.float32))
    ang = jnp.arange(S, dtype=jnp.float32)[:, None] * inv[None, :]
    cos = jnp.cos(ang)[None, :, None, :]
    sin = jnp.sin(ang)[None, :, None, :]
    tf = t.astype(jnp.float32)
    t1, t2 = tf[..., :half], tf[..., half:]
    return jnp.concatenate([t1 * cos - t2 * sin, t1 * sin + t2 * cos], axis=-1)


def retention(q, k, v):
    B, S, H, Dk = q.shape
    Dv = v.shape[-1]
    C = math.gcd(S, RET_CHUNK)
    N = S // C
    log_g = jnp.log1p(-(2.0 ** (-5.0 - jnp.arange(H, dtype=jnp.float32))))
    qc = q.reshape(B, N, C, H, Dk)
    kc = k.reshape(B, N, C, H, Dk)
    vc = v.astype(jnp.float32).reshape(B, N, C, H, Dv)
    pos = jnp.arange(C, dtype=jnp.float32)
    rel = pos[:, None] - pos[None, :]
    decay_in = jnp.where(rel >= 0, jnp.exp(jnp.maximum(rel, 0.0)[None] * log_g[:, None, None]), 0.0)
    xi = jnp.exp((pos[None, :] + 1.0) * log_g[:, None])
    zeta = jnp.exp((C - 1.0 - pos[None, :]) * log_g[:, None])
    g_chunk = jnp.exp(C * log_g)
    s = jnp.einsum('bnqhd,bnkhd->bnhqk', qc, kc) * decay_in[None, None]
    o_in = jnp.einsum('bnhqk,bnkhe->bnqhe', s, vc)
    U = jnp.einsum('bnkhd,hk,bnkhe->bnhde', kc, zeta, vc)

    def step(R, U_n):
        return g_chunk[None, :, None, None] * R + U_n, R

    _, R_prev = lax.scan(step, jnp.zeros_like(U[:, 0]), jnp.moveaxis(U, 1, 0))
    cross = jnp.einsum('bnqhd,nbhde->bnqhe', qc, R_prev) * xi.T[None, None, :, :, None]
    return (o_in + cross).reshape(B, S, H, Dv)


def memory_branch(mq, gate, mem_n, w_mem_kv):
    B, S, _ = mq.shape
    M = mem_n.shape[1]
    mk, mv = split_cols(mem_n @ w_mem_kv, [MEM_W, MEM_W])
    q = mq.reshape(B, S, MEM_HEADS, MEM_DH)
    k = mk.reshape(B, M, MEM_HEADS, MEM_DH)
    v = mv.reshape(B, M, MEM_HEADS, MEM_DH)
    s = jnp.einsum('bshd,bmhd->bhsm', q, k).astype(jnp.float32) * (MEM_DH ** -0.5)
    p = jax.nn.softmax(s, axis=-1)
    o = jnp.einsum('bhsm,bmhd->bshd', p.astype(v.dtype), v).reshape(B, S, MEM_W)
    return o * jax.nn.silu(gate)


def dilated_group(q, k, v, dil, span):
    B, S, H, D = q.shape
    n = S // dil
    Qb = math.gcd(n, DIL_BLOCK)
    nb = n // Qb

    def to_res(t):
        return t.reshape(B, n, dil, H, D).transpose(0, 2, 1, 3, 4)

    qr = to_res(q).reshape(B, dil, nb, Qb, H, D)
    pad = ((0, 0), (0, 0), (span, 0), (0, 0), (0, 0))
    kr = jnp.pad(to_res(k), pad)
    vr = jnp.pad(to_res(v), pad)
    idx = jnp.arange(nb)[:, None] * Qb + jnp.arange(Qb + span)[None, :]
    kb = kr[:, :, idx]
    vb = vr[:, :, idx]
    dist = jnp.arange(Qb)[:, None] + span - jnp.arange(Qb + span)[None, :]
    band = (dist >= 0) & (dist <= span)
    mask = band[None] & ((idx - span)[:, None, :] >= 0)
    s = jnp.einsum('bgnqhd,bgnkhd->bgnhqk', qr, kb).astype(jnp.float32) * (D ** -0.5)
    s = jnp.where(mask[None, None, :, None], s, -1e30)
    m = jnp.max(s, axis=-1, keepdims=True)
    p = jnp.exp(s - m)
    l = jnp.sum(p, axis=-1)
    o = jnp.einsum('bgnhqk,bgnkhd->bgnqhd', p, vb.astype(jnp.float32))
    o = o / jnp.transpose(l, (0, 1, 2, 4, 3))[..., None]
    lse = jnp.transpose(m[..., 0] + jnp.log(l), (0, 1, 2, 4, 3))
    o = o.reshape(B, dil, n, H, D).transpose(0, 2, 1, 3, 4).reshape(B, S, H, D)
    lse = lse.reshape(B, dil, n, H).transpose(0, 2, 1, 3).reshape(B, S, H)
    return o, lse


def retention_layer(x, g, w_in, w_mem_kv, w_out, mem_n):
    B, S, _ = x.shape
    h = rmsnorm(x, g)
    q, k, v, gate_r, mq, gate_m = split_cols(h @ w_in, [RET_QK_W, RET_QK_W, RET_V_W, RET_V_W, MEM_W, MEM_W])
    q = rotary(q.reshape(B, S, RET_HEADS, RET_DK))
    k = rotary(k.reshape(B, S, RET_HEADS, RET_DK)) * (RET_DK ** -0.5)
    o = retention(q, k, v.reshape(B, S, RET_HEADS, RET_DV))
    o = o * lax.rsqrt(jnp.mean(o * o, axis=-1, keepdims=True) + EPS)
    o_ret = o.reshape(B, S, RET_V_W).astype(x.dtype) * jax.nn.silu(gate_r)
    o_mem = memory_branch(mq, gate_m, mem_n, w_mem_kv)
    return x + jnp.concatenate([o_ret, o_mem], axis=-1) @ w_out


def shared_kv(x, g, w_kv):
    B, S, _ = x.shape
    parts = split_cols(rmsnorm(x, g) @ w_kv, [DIL_W] * (2 * len(DIL_CONFIG)))
    return [t.reshape(B, S, DIL_HEADS, DIL_DH) for t in parts]


def dilated_layer(x, g, w_in, w_mem_kv, w_out, mem_n, kv):
    B, S, _ = x.shape
    h = rmsnorm(x, g)
    n_g = len(DIL_CONFIG)
    parts = split_cols(h @ w_in, [DIL_W] * n_g + [DIL_W, MEM_W, MEM_W])
    gate_d, mq, gate_m = parts[n_g], parts[n_g + 1], parts[n_g + 2]
    outs, lses = [], []
    for gi, (window, dil) in enumerate(DIL_CONFIG):
        q = parts[gi].reshape(B, S, DIL_HEADS, DIL_DH)
        o, lse = dilated_group(q, kv[2 * gi], kv[2 * gi + 1], dil, window // dil)
        outs.append(o)
        lses.append(lse)
    alpha = jax.nn.softmax(jnp.stack(lses, axis=0), axis=0)
    o = jnp.sum(alpha[..., None] * jnp.stack(outs, axis=0), axis=0)
    o_dil = o.reshape(B, S, DIL_W).astype(x.dtype) * jax.nn.silu(gate_d)
    o_mem = memory_branch(mq, gate_m, mem_n, w_mem_kv)
    return x + jnp.concatenate([o_dil, o_mem], axis=-1) @ w_out


def setup_inputs(seed: int = 0) -> dict:
    key = jax.random.key(seed)
    ks = jax.random.split(key, 14)
    f32 = jnp.float32

    def w(k, shape, fan_in):
        return jax.random.normal(k, shape, f32) * (fan_in ** -0.5)

    def gain(k, shape):
        return 1.0 + 0.02 * jax.random.normal(k, shape, f32)

    return {
        "x": jax.random.normal(ks[0], (BATCH, SEQ, D_MODEL), f32),
        "mem": jax.random.normal(ks[1], (BATCH, MEM_LEN, D_MODEL), f32),
        "norm_a": gain(ks[2], (N_A, D_MODEL)),
        "w_in_a": w(ks[3], (N_A, D_MODEL, IN_W_A), D_MODEL),
        "w_out_a": w(ks[4], (N_A, MIX_W_A, D_MODEL), MIX_W_A),
        "norm_b": gain(ks[5], (N_B, D_MODEL)),
        "w_in_b": w(ks[6], (N_B, D_MODEL, IN_W_B), D_MODEL),
        "w_out_b": w(ks[7], (N_B, MIX_W_B, D_MODEL), MIX_W_B),
        "w_mem_kv": w(ks[8], (DEPTH, D_MODEL, 2 * MEM_W), D_MODEL),
        "mem_norm_g": gain(ks[9], (D_MODEL,)),
        "kv_norm_g": gain(ks[10], (D_MODEL,)),
        "w_kv": w(ks[11], (D_MODEL, KV_W), D_MODEL),
        "final_norm_g": gain(ks[12], (D_MODEL,)),
    }


def reference(x, mem, norm_a, w_in_a, w_out_a, norm_b, w_in_b, w_out_b, w_mem_kv, mem_norm_g, kv_norm_g, w_kv, final_norm_g):
    mem_n = rmsnorm(mem, mem_norm_g)
    kv = None
    for layer in range(DEPTH):
        if layer < N_A:
            x = retention_layer(x, norm_a[layer], w_in_a[layer], w_mem_kv[layer], w_out_a[layer], mem_n)
            if layer == N_A - 1:
                kv = shared_kv(x, kv_norm_g, w_kv)
        else:
            j = layer - N_A
            x = dilated_layer(x, norm_b[j], w_in_b[j], w_mem_kv[layer], w_out_b[j], mem_n, kv)
    return rmsnorm(x, final_norm_g)
```

```cpp
#include <hip/hip_runtime.h>
#include <hip/hip_cooperative_groups.h>
#include <cstdio>
#include <cstdint>
namespace cg = cooperative_groups;

#ifndef MK_SPLIT
#define MK_SPLIT 0
#endif

#ifndef PROBE_GEMM
#define PROBE_GEMM 0
#endif
#ifndef PROBE_RET
#define PROBE_RET 0
#endif
#ifndef PROBE_ATTN
#define PROBE_ATTN 0
#endif
#define LAS __attribute__((address_space(3)))
#define DI __device__ __forceinline__
typedef unsigned short bf16_t;
typedef short bf16x8 __attribute__((ext_vector_type(8)));
typedef short s16x4 __attribute__((ext_vector_type(4)));
typedef float f32x4 __attribute__((ext_vector_type(4)));
typedef float f32x16 __attribute__((ext_vector_type(16)));
typedef unsigned u32x4 __attribute__((ext_vector_type(4)));
typedef unsigned u32x2 __attribute__((ext_vector_type(2)));
typedef __bf16 nbf16x2 __attribute__((ext_vector_type(2)));

constexpr int NT = 512;
constexpr int T_TOK = 16384, DM = 2048, SEQ = 4096;
constexpr int LDS_BYTES = 144 * 1024;
constexpr float EPS = 1e-6f;
constexpr float LOG2E = 1.4426950408889634f, LN2 = 0.6931471805599453f;

constexpr size_t MiB = 1048576;
constexpr size_t WS_KV   = 0;
constexpr size_t WS_PROJA = 0;
constexpr size_t WS_MIXA = 256 * MiB;
constexpr size_t WS_WMEMT = 352 * MiB;
constexpr size_t WS_P    = 384 * MiB;
constexpr size_t WS_HA   = 384 * MiB;
constexpr size_t WS_RPREV = 448 * MiB;
constexpr size_t WS_WKVT = 448 * MiB;
constexpr size_t WS_MEMN = 512 * MiB;
constexpr size_t WS_HB   = 544 * MiB;
constexpr size_t WS_WIN  = 576 * MiB;
constexpr size_t WS_WOUT = 616 * MiB;
constexpr size_t WS_MEMKV = 628 * MiB;
constexpr size_t WS_COS  = 644 * MiB;
constexpr size_t WS_SIN  = 645 * MiB;
constexpr size_t WS_LSE  = 646 * MiB;
constexpr size_t WS_BAR  = 648 * MiB;
constexpr size_t WS_END  = 648 * MiB + 16384;

DI unsigned pk2(float a, float b) { nbf16x2 v; v[0] = (__bf16)a; v[1] = (__bf16)b; return __builtin_bit_cast(unsigned, v); }
DI float bflo(unsigned u) { return __uint_as_float(u << 16); }
DI float bfhi(unsigned u) { return __uint_as_float(u & 0xffff0000u); }
DI float silu_f(float x) { return x / (1.f + __expf(-x)); }
DI int crow(int i, int h) { return (i & 3) + 8 * (i >> 2) + 4 * h; }
DI float wave_sum(float v) {
#pragma unroll
    for (int o = 32; o >= 1; o >>= 1) v += __shfl_xor(v, o);
    return v;
}
#define MFMA32(a, b, c) __builtin_amdgcn_mfma_f32_32x32x16_bf16((a), (b), (c), 0, 0, 0)
template <int S> DI bf16x8 pack8(const f32x16& x) {
    u32x4 p; p[0] = pk2(x[8 * S], x[8 * S + 1]); p[1] = pk2(x[8 * S + 2], x[8 * S + 3]); p[2] = pk2(x[8 * S + 4], x[8 * S + 5]); p[3] = pk2(x[8 * S + 6], x[8 * S + 7]);
    return __builtin_bit_cast(bf16x8, p);
}
DI bf16x8 tr_pair(LAS unsigned char* lo_p, LAS unsigned char* hi_p) {
    s16x4 lo = __builtin_amdgcn_ds_read_tr16_b64_v4i16((LAS s16x4*)lo_p);
    s16x4 hi = __builtin_amdgcn_ds_read_tr16_b64_v4i16((LAS s16x4*)hi_p);
    return __builtin_shufflevector(lo, hi, 0, 1, 2, 3, 4, 5, 6, 7);
}
DI f32x16 zero16() { f32x16 z; for (int i = 0; i < 16; ++i) z[i] = 0.f; return z; }

namespace pg8 {
constexpr int BM = 256, BK = 64, HALF = 128, HTB = HALF * BK * 2, STAGE_BYTES = 8 * HTB, NXCD = 8, WGM = 8;
DI int lds_byte(int r, int c) { const int st = (r >> 4) * 2 + (c >> 5), rr = r & 15, cc = c & 31, ob = rr * 64 + cc * 2; return st * 1024 + (ob ^ (((ob >> 9) & 1) << 5)); }
DI void stage_rc(int b, int& R, int& C) { const int st = b / 1024, sb = b % 1024, swz = sb ^ (((sb >> 9) & 1) << 5); R = (st >> 1) * 16 + swz / 64; C = (st & 1) * 32 + (swz % 64) / 2; }
DI int perm32(int rho) { const int n = rho >> 4, i = rho & 15; return 8 * (i >> 2) + 4 * n + (i & 3); }
struct Unit { int pm, pn; };
struct Gemm { const bf16_t* A; const bf16_t* Bt; int M, N, K, lda, dil; };
struct StaticOrder {
    int nM, nN, nwg, G, c;
    DI void init(int M, int N, int G_, int c_) { nM = M / BM; nN = N / BM; nwg = nM * nN; G = G_; c = c_; }
    DI bool next(int i, Unit& u) const {
        const long L = (long)i * G + c; if (L >= nwg) return false;
        int wgid = (int)L; { const int q = nwg / NXCD, r = nwg % NXCD, xcd = wgid % NXCD, off = wgid / NXCD; wgid = (xcd < r ? xcd * (q + 1) : r * (q + 1) + (xcd - r) * q) + off; }
        const int nig = WGM * nN, gid = wgid / nig, fm = gid * WGM, gsz = (nM - fm) < WGM ? (nM - fm) : WGM;
        u.pm = fm + ((wgid % nig) % gsz); u.pn = (wgid % nig) / gsz; return true;
    }
};
DI size_t arow0(int pm, int dil) {
    const int m0 = pm * BM; if (dil == 1) return (size_t)m0;
    const int b = m0 >> 12, rem = m0 & 4095, n = 4096 / dil, r = rem / n, i0 = rem % n;
    return (size_t)(b * 4096 + i0 * dil + r);
}
struct EpiBf16 {
    static constexpr bool PERM = true;
    bf16_t* O; int ldc; int hm; const float* ss; int dil;
    DI void operator()(const f32x4 (&acc)[2][2][4][2], const Unit& u, int wr, int wc, int fr, int fq) const {
        const int row0 = u.pm * BM + wr * 64 + fr, col0 = u.pn * BM + wc * 32 + 8 * fq;
#pragma unroll
        for (int ai = 0; ai < 2; ++ai)
#pragma unroll
            for (int m = 0; m < 4; ++m) { const int row = row0 + ai * HALF + m * 16;
#pragma unroll
                for (int bj = 0; bj < 2; ++bj) { const f32x4 v0 = acc[ai][bj][m][0], v1 = acc[ai][bj][m][1];
                    u32x4 w; w.x = pk2(v0[0], v0[1]); w.y = pk2(v0[2], v0[3]); w.z = pk2(v1[0], v1[1]); w.w = pk2(v1[2], v1[3]);
                    const int col = col0 + bj * HALF;
                    bf16_t* dst = hm ? O + ((size_t)(col >> 7) * T_TOK + row) * 128 + (col & 127) : O + (size_t)row * ldc + col;
                    *(u32x4*)dst = w; } }
    }
};
struct EpiRes {
    static constexpr bool PERM = true;
    const float* xin; float* xout;
    DI void operator()(const f32x4 (&acc)[2][2][4][2], const Unit& u, int wr, int wc, int fr, int fq) const {
        const int row0 = u.pm * BM + wr * 64 + fr, col0 = u.pn * BM + wc * 32 + 8 * fq;
#pragma unroll
        for (int ai = 0; ai < 2; ++ai)
#pragma unroll
            for (int m = 0; m < 4; ++m) { const size_t off = (size_t)(row0 + ai * HALF + m * 16) * DM + col0;
                f32x4 b[2][2];
#pragma unroll
                for (int bj = 0; bj < 2; ++bj)
#pragma unroll
                    for (int n = 0; n < 2; ++n) b[bj][n] = *(const f32x4*)(xin + off + bj * HALF + n * 4);
#pragma unroll
                for (int bj = 0; bj < 2; ++bj)
#pragma unroll
                    for (int n = 0; n < 2; ++n) *(f32x4*)(xout + off + bj * HALF + n * 4) = b[bj][n] + acc[ai][bj][m][n]; }
    }
};

template <class Epi>
DI void gemm_phase(LAS unsigned char* lds, const Gemm g, const StaticOrder& S, const Epi& E) {
    int tid = threadIdx.x;
    asm volatile("" : "+v"(tid)); __builtin_assume(tid >= 0 && tid < NT);
    const int wid = __builtin_amdgcn_readfirstlane(tid >> 6), lane = tid & 63, wr = wid >> 2, wc = wid & 3, fr = lane & 15, fq = lane >> 4;
    const int K = g.K, nt = K / BK;
    unsigned voffA[2], voffB[2];
#pragma unroll
    for (int i = 0; i < 2; ++i) { int R, C; stage_rc(tid * 16 + i * 8192, R, C); const int Rb = Epi::PERM ? ((R & ~31) + perm32(R & 31)) : R;
        voffA[i] = (unsigned)(R * g.dil * g.lda + C) * 2u; voffB[i] = (unsigned)(Rb * K + C) * 2u; }
    const size_t kstep = (size_t)(BK * 2);
    const size_t hstepA = (size_t)HALF * g.dil * g.lda * 2, hstepB = (size_t)HALF * K * 2, tstepB = 2 * hstepB;
    const unsigned ldsw = (unsigned)wid * 1024u;
    const int aoff = lds_byte(wr * 64 + fr, fq * 8), boff = lds_byte(wc * 32 + fr, fq * 8);
#define PG8_SA(b, h) (((b) * 2 + (h)) * HTB)
#define PG8_SB(b, h) ((4 + (b) * 2 + (h)) * HTB)
#define PG8_STAGE(bufoff, gbase, voff) do { _Pragma("unroll") for (int _i = 0; _i < 2; ++_i) \
        __builtin_amdgcn_global_load_lds((const unsigned*)((const char*)(gbase) + (voff)[_i]), (LAS unsigned*)(lds + (bufoff) + ldsw + _i * 8192), 16, 0, 0); } while (0)
#define PG8_LDA(dst, b, h) do { _Pragma("unroll") for (int m = 0; m < 4; ++m) _Pragma("unroll") for (int k = 0; k < 2; ++k) dst[m][k] = *(const LAS bf16x8*)(lds + PG8_SA(b, h) + aoff + m * 2048 + k * 1024); } while (0)
#define PG8_LDB(dst, b, h) do { _Pragma("unroll") for (int n = 0; n < 2; ++n) _Pragma("unroll") for (int k = 0; k < 2; ++k) dst[n][k] = *(const LAS bf16x8*)(lds + PG8_SB(b, h) + boff + n * 2048 + k * 1024); } while (0)
#define PG8_MMA(ai, bj, At, Bt) do { __builtin_amdgcn_s_setprio(1); _Pragma("unroll") for (int m = 0; m < 4; ++m) _Pragma("unroll") for (int n = 0; n < 2; ++n) _Pragma("unroll") for (int k = 0; k < 2; ++k) \
        acc[ai][bj][m][n] = __builtin_amdgcn_mfma_f32_16x16x32_bf16(Bt[n][k], At[m][k], acc[ai][bj][m][n], 0, 0, 0); __builtin_amdgcn_s_setprio(0); } while (0)
#define PG8_WAIT_V(n) asm volatile("s_waitcnt vmcnt(" #n ")" ::: "memory")
#define PG8_WAIT_L(n) asm volatile("s_waitcnt lgkmcnt(" #n ")" ::: "memory")
#define PG8_BAR __builtin_amdgcn_s_barrier()
#define PG8_SCHED __builtin_amdgcn_sched_barrier(0)
    Unit cur, nxt; int ui = 0;
    if (!S.next(0, cur)) return;
    f32x4 acc[2][2][4][2];
#pragma unroll
    for (int a = 0; a < 2; ++a)
#pragma unroll
        for (int b = 0; b < 2; ++b)
#pragma unroll
            for (int m = 0; m < 4; ++m)
#pragma unroll
                for (int n = 0; n < 2; ++n) acc[a][b][m][n] = (f32x4){0.f, 0.f, 0.f, 0.f};
    bf16x8 At[4][2], B0[2][2], B1[2][2];
    const char* cA = (const char*)g.A + arow0(cur.pm, g.dil) * (size_t)g.lda * 2; const char* cB = (const char*)g.Bt + (size_t)cur.pn * tstepB;
    PG8_STAGE(PG8_SB(0, 0), cB, voffB); PG8_STAGE(PG8_SB(0, 1), cB + hstepB, voffB); PG8_STAGE(PG8_SA(0, 0), cA, voffA); PG8_STAGE(PG8_SA(0, 1), cA + hstepA, voffA);
    if (wr == 1) PG8_BAR;
    PG8_WAIT_V(2); PG8_BAR;
    PG8_STAGE(PG8_SB(1, 0), cB + kstep, voffB); PG8_STAGE(PG8_SA(1, 0), cA + kstep, voffA); PG8_STAGE(PG8_SB(1, 1), cB + hstepB + kstep, voffB);
    PG8_WAIT_V(6); PG8_BAR;
    for (;;) {
        const bool has_next = S.next(ui + 1, nxt);
        const char* nA = has_next ? (const char*)g.A + arow0(nxt.pm, g.dil) * (size_t)g.lda * 2 : cA; const char* nB = has_next ? (const char*)g.Bt + (size_t)nxt.pn * tstepB : cB;
        for (int t = 0; t < nt; t += 2) {
            const bool last = (t == nt - 2);
            const char* a1 = cA + (size_t)(t + 1) * kstep;
            const char* a2 = last ? nA : cA + (size_t)(t + 2) * kstep; const char* b2 = last ? nB : cB + (size_t)(t + 2) * kstep;
            const char* a3 = a2 + kstep; const char* b3 = b2 + kstep;
            PG8_LDB(B0, 0, 0); PG8_LDB(B1, 0, 1); PG8_SCHED; PG8_LDA(At, 0, 0); PG8_STAGE(PG8_SA(1, 1), a1 + hstepA, voffA);
            PG8_WAIT_V(8); PG8_WAIT_L(0); PG8_BAR; PG8_MMA(0, 0, At, B0); PG8_MMA(0, 1, At, B1); PG8_BAR; PG8_SCHED;
            PG8_LDA(At, 0, 1); PG8_STAGE(PG8_SB(0, 0), b2, voffB); PG8_STAGE(PG8_SB(0, 1), b2 + hstepB, voffB); PG8_STAGE(PG8_SA(0, 0), a2, voffA);
            PG8_WAIT_V(8); PG8_WAIT_L(0); PG8_BAR; PG8_MMA(1, 0, At, B0); PG8_MMA(1, 1, At, B1); PG8_BAR; PG8_SCHED;
            PG8_LDB(B0, 1, 0); PG8_LDB(B1, 1, 1); PG8_SCHED; PG8_LDA(At, 1, 0); PG8_STAGE(PG8_SA(0, 1), a2 + hstepA, voffA);
            PG8_WAIT_V(8); PG8_WAIT_L(0); PG8_BAR; PG8_MMA(0, 0, At, B0); PG8_MMA(0, 1, At, B1); PG8_BAR; PG8_SCHED;
            PG8_LDA(At, 1, 1); PG8_STAGE(PG8_SB(1, 0), b3, voffB); PG8_STAGE(PG8_SB(1, 1), b3 + hstepB, voffB); PG8_STAGE(PG8_SA(1, 0), a3, voffA);
            PG8_WAIT_V(8); PG8_WAIT_L(0); PG8_BAR; PG8_MMA(1, 0, At, B0); PG8_MMA(1, 1, At, B1); PG8_BAR; PG8_SCHED;
        }
        if (wr == 0) PG8_BAR;
        E(acc, cur, wr, wc, fr, fq);
        if (!has_next) break;
#pragma unroll
        for (int a = 0; a < 2; ++a)
#pragma unroll
            for (int b = 0; b < 2; ++b)
#pragma unroll
                for (int m = 0; m < 4; ++m)
#pragma unroll
                    for (int n = 0; n < 2; ++n) acc[a][b][m][n] = (f32x4){0.f, 0.f, 0.f, 0.f};
        cur = nxt; cA = nA; cB = nB; ++ui;
        if (wr == 1) PG8_BAR;
    }
    PG8_WAIT_V(0);
    PG8_BAR;
#undef PG8_SA
#undef PG8_SB
#undef PG8_STAGE
#undef PG8_LDA
#undef PG8_LDB
#undef PG8_MMA
#undef PG8_WAIT_V
#undef PG8_WAIT_L
#undef PG8_BAR
#undef PG8_SCHED
}
}

template <int NCH, int CPR>
DI void load_rows(LAS unsigned char* dst, int dstride, const bf16_t* src, size_t ld, int zrows, int tid) {
    u32x4 v[NCH];
#pragma unroll
    for (int j = 0; j < NCH; ++j) { const int c = tid + NT * j, row = c / CPR, ch = c % CPR;
        v[j] = (u32x4){0u, 0u, 0u, 0u};
        if (row >= zrows) v[j] = *(const u32x4*)(src + (ptrdiff_t)row * (ptrdiff_t)ld + ch * 8); }
#pragma unroll
    for (int j = 0; j < NCH; ++j) { const int c = tid + NT * j, row = c / CPR, ch = c % CPR;
        *(LAS u32x4*)(dst + row * dstride + ch * 16) = v[j]; }
}
template <int NCH, int CPR>
DI void ld_issue(u32x4 (&v)[NCH], const bf16_t* src, size_t ld, int zrows, int tid) {
#pragma unroll
    for (int j = 0; j < NCH; ++j) { const int c = tid + NT * j, row = c / CPR, ch = c % CPR;
        v[j] = (u32x4){0u, 0u, 0u, 0u};
        if (row >= zrows) v[j] = *(const u32x4*)(src + (ptrdiff_t)row * (ptrdiff_t)ld + ch * 8); }
}
template <int NCH, int CPR>
DI void ld_commit(LAS unsigned char* dst, int dstride, const u32x4 (&v)[NCH], int tid) {
#pragma unroll
    for (int j = 0; j < NCH; ++j) { const int c = tid + NT * j, row = c / CPR, ch = c % CPR;
        *(LAS u32x4*)(dst + row * dstride + ch * 16) = v[j]; }
}
template <bool ZETA>
DI void load_rot(LAS unsigned char* dst, int dstride, const bf16_t* src, size_t ld, const float* cosT, const float* sinT, int pos0, float scale, float log2g, int tid) {
#pragma unroll
    for (int j = 0; j < 2; ++j) {
        const int c = tid + NT * j, row = c >> 3, ch = c & 7;
        const bf16_t* p = src + (size_t)row * ld + ch * 8;
        const u32x4 a = *(const u32x4*)p, b = *(const u32x4*)(p + 64);
        const float* cp = cosT + (size_t)(pos0 + row) * 64 + ch * 8; const float* sp = sinT + (size_t)(pos0 + row) * 64 + ch * 8;
        const f32x4 c0 = *(const f32x4*)cp, c1 = *(const f32x4*)(cp + 4), s0 = *(const f32x4*)sp, s1 = *(const f32x4*)(sp + 4);
        float f = scale; if (ZETA) f *= exp2f((float)(127 - row) * log2g);
        u32x4 o1, o2;
#pragma unroll
        for (int k = 0; k < 4; ++k) {
            const float x1a = bflo(a[k]), x1b = bfhi(a[k]), x2a = bflo(b[k]), x2b = bfhi(b[k]);
            const float ca = (k < 2) ? c0[2 * k] : c1[2 * k - 4], cb = (k < 2) ? c0[2 * k + 1] : c1[2 * k - 3];
            const float sa = (k < 2) ? s0[2 * k] : s1[2 * k - 4], sb = (k < 2) ? s0[2 * k + 1] : s1[2 * k - 3];
            o1[k] = pk2((x1a * ca - x2a * sa) * f, (x1b * cb - x2b * sb) * f);
            o2[k] = pk2((x1a * sa + x2a * ca) * f, (x1b * sb + x2b * cb) * f);
        }
        *(LAS u32x4*)(dst + row * dstride + ch * 16) = o1;
        *(LAS u32x4*)(dst + row * dstride + 128 + ch * 16) = o2;
    }
}

DI void transpose_seg(const float* W, int K, int N, int nsrc0, int ncols, bf16_t* WT, int drow0, LAS float* scr, int gw, int ngw, int lane) {
    const int nblk = ncols / 64, nitems = (K / 64) * nblk;
    const int kk4 = lane >> 4, c4 = (lane & 15) * 4, c = lane & 7, n8 = lane >> 3;
    for (int item = gw; item < nitems; item += ngw) {
        const int kb = item / nblk, nb = item % nblk, k0 = 64 * kb, n0 = 64 * nb;
        const float* src = W + (size_t)(k0 + kk4) * N + nsrc0 + n0 + c4;
        f32x4 v[16];
#pragma unroll
        for (int i = 0; i < 16; ++i) v[i] = *(const f32x4*)(src + (size_t)(4 * i) * N);
#pragma unroll
        for (int i = 0; i < 16; ++i) { LAS float* d = scr + (4 * i + kk4) * 65 + c4; d[0] = v[i].x; d[1] = v[i].y; d[2] = v[i].z; d[3] = v[i].w; }
        asm volatile("s_waitcnt lgkmcnt(0)" ::: "memory");
#pragma unroll
        for (int j = 0; j < 8; ++j) { const int n = n8 + 8 * j; const LAS float* s = scr + (8 * c) * 65 + n;
            u32x4 o; o.x = pk2(s[0 * 65], s[1 * 65]); o.y = pk2(s[2 * 65], s[3 * 65]); o.z = pk2(s[4 * 65], s[5 * 65]); o.w = pk2(s[6 * 65], s[7 * 65]);
            *(u32x4*)(WT + (size_t)(drow0 + n0 + n) * K + k0 + 8 * c) = o; }
        asm volatile("s_waitcnt lgkmcnt(0)" ::: "memory");
    }
}
DI void norm_row_bf16(const float* xr, const float* g, bf16_t* o, int lane) {
    f32x4 v[8]; float s = 0.f;
#pragma unroll
    for (int j = 0; j < 8; ++j) { v[j] = ((const f32x4*)xr)[lane + 64 * j]; s += (v[j].x * v[j].x + v[j].y * v[j].y) + (v[j].z * v[j].z + v[j].w * v[j].w); }
    const float rstd = rsqrtf(wave_sum(s) * (1.f / DM) + EPS);
#pragma unroll
    for (int j = 0; j < 8; ++j) { const f32x4 gg = ((const f32x4*)g)[lane + 64 * j];
        u32x2 w; w.x = pk2(v[j].x * rstd * gg.x, v[j].y * rstd * gg.y); w.y = pk2(v[j].z * rstd * gg.z, v[j].w * rstd * gg.w);
        ((u32x2*)o)[lane + 64 * j] = w; }
}
DI void norm_rows(const float* x, const float* g, bf16_t* o, int nrows, int gw, int ngw, int lane) {
    for (int m = gw; m < nrows; m += ngw) norm_row_bf16(x + (size_t)m * DM, g, o + (size_t)m * DM, lane);
}

DI void ret_state_item(LAS unsigned char* lds, const bf16_t* projA, bf16_t* rprev, const float* cosT, const float* sinT, int item, int tid) {
    asm volatile("" : "+v"(tid)); __builtin_assume(tid >= 0 && tid < NT);
    const int lane = tid & 63, w = __builtin_amdgcn_readfirstlane(tid >> 6), h = lane >> 5, blk = (lane >> 4) & 1, q4 = (lane & 15) >> 2, p4 = lane & 3;
    const int es = item & 3, hh = (item >> 2) & 7, b = item >> 5;
    const int et = w & 1, dt = w >> 1;
    const float log2g = log2f(1.f - exp2f(-5.f - (float)hh));
    const float gchunk = exp2f(128.f * log2g);
    LAS unsigned char* Kz = lds;
    LAS unsigned char* Vz = lds + 128 * 320;
    f32x16 acc = zero16();
    for (int n = 0; n < 32; ++n) {
        bf16_t* rp = rprev + ((size_t)((b * 8 + hh) * 32 + n) * 256 + 64 * es + 32 * et) * 128 + 32 * dt + (lane & 31);
#pragma unroll
        for (int i = 0; i < 16; ++i) rp[(size_t)crow(i, h) * 128] = (bf16_t)(pk2(acc[i], 0.f) & 0xffffu);
        if (n == 31) break;
        const size_t row0 = (size_t)b * SEQ + n * 128;
        load_rot<true>(Kz, 320, projA + row0 * 8192 + 1024 + hh * 128, 8192, cosT, sinT, n * 128, 0.08838834764831845f, log2g, tid);
        load_rows<2, 8>(Vz, 192, projA + row0 * 8192 + 2048 + hh * 256 + 64 * es, 8192, 0, tid);
        __syncthreads();
#pragma unroll
        for (int i = 0; i < 16; ++i) acc[i] *= gchunk;
#pragma unroll
        for (int ks = 0; ks < 8; ++ks) {
            const int r0 = 16 * ks + 8 * h + q4;
            const bf16x8 a = tr_pair(Vz + r0 * 192 + (32 * et + 16 * blk + 4 * p4) * 2, Vz + (r0 + 4) * 192 + (32 * et + 16 * blk + 4 * p4) * 2);
            const bf16x8 bb = tr_pair(Kz + r0 * 320 + (32 * dt + 16 * blk + 4 * p4) * 2, Kz + (r0 + 4) * 320 + (32 * dt + 16 * blk + 4 * p4) * 2);
            acc = MFMA32(a, bb, acc);
        }
        __syncthreads();
    }
}

DI void ret_out_item(LAS unsigned char* lds, const bf16_t* projA, const bf16_t* rprev, bf16_t* mix, const float* cosT, const float* sinT, int item, int tid) {
    asm volatile("" : "+v"(tid)); __builtin_assume(tid >= 0 && tid < NT);
    const int lane = tid & 63, w = __builtin_amdgcn_readfirstlane(tid >> 6), h = lane >> 5, blk = (lane >> 4) & 1, q4 = (lane & 15) >> 2, p4 = lane & 3, ql = lane & 31;
    const int n = item & 31, hh = (item >> 5) & 7, b = item >> 8;
    const int qsub = w & 3, eh = w >> 2;
    const float log2g = log2f(1.f - exp2f(-5.f - (float)hh));
    LAS unsigned char* Qs = lds;
    LAS unsigned char* Ks = lds + 34816;
    LAS unsigned char* Rs = lds + 69632;
    LAS unsigned char* Vs = lds;
    LAS float* red = (LAS float*)(lds + 139264);
    const size_t row0 = (size_t)b * SEQ + n * 128;
    __syncthreads();
    load_rot<false>(Qs, 272, projA + row0 * 8192 + hh * 128, 8192, cosT, sinT, n * 128, 1.f, 0.f, tid);
    load_rot<false>(Ks, 272, projA + row0 * 8192 + 1024 + hh * 128, 8192, cosT, sinT, n * 128, 0.08838834764831845f, 0.f, tid);
    load_rows<8, 16>(Rs, 272, rprev + (size_t)((b * 8 + hh) * 32 + n) * 256 * 128, 128, 0, tid);
    __syncthreads();
    bf16x8 qf[8];
#pragma unroll
    for (int ks = 0; ks < 8; ++ks) qf[ks] = *(const LAS bf16x8*)(Qs + (32 * qsub + ql) * 272 + (16 * ks + 8 * h) * 2);
    bf16x8 pf[4][2];
#pragma unroll
    for (int kt = 0; kt < 4; ++kt) {
        if (kt <= qsub) {
            f32x16 s = zero16();
#pragma unroll
            for (int ks = 0; ks < 8; ++ks) { const bf16x8 a = *(const LAS bf16x8*)(Ks + (32 * kt + ql) * 272 + (16 * ks + 8 * h) * 2); s = MFMA32(a, qf[ks], s); }
#pragma unroll
            for (int i = 0; i < 16; ++i) { const int dq = (32 * qsub + ql) - (32 * kt + crow(i, h)); s[i] = (dq >= 0) ? s[i] * __builtin_amdgcn_exp2f((float)dq * log2g) : 0.f; }
            pf[kt][0] = pack8<0>(s); pf[kt][1] = pack8<1>(s);
            __builtin_amdgcn_sched_barrier(0);
        } else { pf[kt][0] = (bf16x8){0, 0, 0, 0, 0, 0, 0, 0}; pf[kt][1] = pf[kt][0]; }
    }
    f32x16 o[4];
    const float xi = exp2f((float)(32 * qsub + ql + 1) * log2g);
#pragma unroll
    for (int et = 0; et < 4; ++et) {
        o[et] = zero16();
#pragma unroll
        for (int ks = 0; ks < 8; ++ks) { const bf16x8 a = *(const LAS bf16x8*)(Rs + (128 * eh + 32 * et + ql) * 272 + (16 * ks + 8 * h) * 2); o[et] = MFMA32(a, qf[ks], o[et]); }
#pragma unroll
        for (int i = 0; i < 16; ++i) o[et][i] *= xi;
    }
    __syncthreads();
    load_rows<8, 32>(Vs, 576, projA + row0 * 8192 + 2048 + hh * 256, 8192, 0, tid);
    __syncthreads();
#pragma unroll
    for (int et = 0; et < 4; ++et)
#pragma unroll
        for (int kt = 0; kt < 4; ++kt)
            if (kt <= qsub) {
#pragma unroll
                for (int s = 0; s < 2; ++s) {
                    const int r0 = 32 * kt + 16 * s + 4 * h + q4; const int cb = (128 * eh + 32 * et + 16 * blk + 4 * p4) * 2;
                    const bf16x8 a = tr_pair(Vs + r0 * 576 + cb, Vs + (r0 + 8) * 576 + cb);
                    o[et] = MFMA32(a, pf[kt][s], o[et]);
                }
            }
    float ss = 0.f;
#pragma unroll
    for (int et = 0; et < 4; ++et)
#pragma unroll
        for (int i = 0; i < 16; ++i) ss += o[et][i] * o[et][i];
    ss += __shfl_xor(ss, 32);
    if (h == 0) red[eh * 128 + 32 * qsub + ql] = ss;
    __syncthreads();
    const float tot = red[32 * qsub + ql] + red[128 + 32 * qsub + ql];
    const float rstd = rsqrtf(tot * (1.f / 256.f) + EPS);
    const size_t tok = row0 + 32 * qsub + ql;
    const bf16_t* gp = projA + tok * 8192 + 4096 + hh * 256 + 128 * eh + 4 * h;
    bf16_t* op = mix + tok * 3072 + hh * 256 + 128 * eh + 4 * h;
#pragma unroll
    for (int et = 0; et < 4; ++et)
#pragma unroll
        for (int i4 = 0; i4 < 4; ++i4) {
            const u32x2 gv = *(const u32x2*)(gp + 32 * et + 8 * i4);
            u32x2 wv;
            wv.x = pk2(o[et][4 * i4] * rstd * silu_f(bflo(gv.x)), o[et][4 * i4 + 1] * rstd * silu_f(bfhi(gv.x)));
            wv.y = pk2(o[et][4 * i4 + 2] * rstd * silu_f(bflo(gv.y)), o[et][4 * i4 + 3] * rstd * silu_f(bfhi(gv.y)));
            *(u32x2*)(op + 32 * et + 8 * i4) = wv;
        }
}

DI void mem_attn_item(LAS unsigned char* lds, const bf16_t* qp, size_t ldq, const bf16_t* gatep, size_t ldg, bf16_t* outp, size_t ldo,
                      const bf16_t* kmem, const bf16_t* vmem, int tid, bool dry = false) {
    asm volatile("" : "+v"(tid)); __builtin_assume(tid >= 0 && tid < NT);
    const int lane = tid & 63, w = __builtin_amdgcn_readfirstlane(tid >> 6), h = lane >> 5, blk = (lane >> 4) & 1, q4 = (lane & 15) >> 2, p4 = lane & 3, ql = lane & 31;
    LAS unsigned char* Ks = lds;
    LAS unsigned char* Vs = lds;
    __syncthreads();
    load_rows<16, 32>(Ks, 528, kmem, 8192, 0, tid);
    __syncthreads();
    const bf16_t* qrow = qp + (size_t)(32 * w + ql) * ldq + 8 * h;
    f32x16 s[8];
#pragma unroll
    for (int kt = 0; kt < 8; ++kt) s[kt] = zero16();
#pragma unroll
    for (int dh = 0; dh < 2; ++dh) {
        bf16x8 qf[8];
#pragma unroll
        for (int ks = 0; ks < 8; ++ks) qf[ks] = *(const bf16x8*)(qrow + 128 * dh + 16 * ks);
#pragma unroll
        for (int kt = 0; kt < 8; ++kt)
#pragma unroll
            for (int ks = 0; ks < 8; ++ks) { const bf16x8 a = *(const LAS bf16x8*)(Ks + (32 * kt + ql) * 528 + (128 * dh + 16 * ks + 8 * h) * 2); s[kt] = MFMA32(a, qf[ks], s[kt]); }
    }
    const float c = 0.0625f * LOG2E;
    float m = -3.0e38f;
#pragma unroll
    for (int kt = 0; kt < 8; ++kt)
#pragma unroll
        for (int i = 0; i < 16; ++i) { s[kt][i] *= c; m = fmaxf(m, s[kt][i]); }
    m = fmaxf(m, __shfl_xor(m, 32));
    float l = 0.f;
    bf16x8 pf[8][2];
#pragma unroll
    for (int kt = 0; kt < 8; ++kt) {
#pragma unroll
        for (int i = 0; i < 16; ++i) { s[kt][i] = __builtin_amdgcn_exp2f(s[kt][i] - m); l += s[kt][i]; }
        pf[kt][0] = pack8<0>(s[kt]); pf[kt][1] = pack8<1>(s[kt]);
        __builtin_amdgcn_sched_barrier(0);
    }
    l += __shfl_xor(l, 32);
    const float rl = 1.f / l;
#pragma unroll
    for (int eh = 0; eh < 2; ++eh) {
        __syncthreads();
        load_rows<8, 16>(Vs, 320, vmem + 128 * eh, 8192, 0, tid);
        __syncthreads();
        f32x16 o[4];
#pragma unroll
        for (int et = 0; et < 4; ++et) {
            o[et] = zero16();
#pragma unroll
            for (int kt = 0; kt < 8; ++kt)
#pragma unroll
                for (int sx = 0; sx < 2; ++sx) {
                    const int r0 = 32 * kt + 16 * sx + 4 * h + q4; const int cb = (32 * et + 16 * blk + 4 * p4) * 2;
                    const bf16x8 a = tr_pair(Vs + r0 * 320 + cb, Vs + (r0 + 8) * 320 + cb);
                    o[et] = MFMA32(a, pf[kt][sx], o[et]);
                }
        }
        const bf16_t* gp = gatep + (size_t)(32 * w + ql) * ldg + 128 * eh + 4 * h;
        bf16_t* op = outp + (size_t)(32 * w + ql) * ldo + 128 * eh + 4 * h;
#pragma unroll
        for (int et = 0; et < 4; ++et)
#pragma unroll
            for (int i4 = 0; i4 < 4; ++i4) {
                const u32x2 gv = *(const u32x2*)(gp + 32 * et + 8 * i4);
                u32x2 wv;
                wv.x = pk2(o[et][4 * i4] * rl * silu_f(bflo(gv.x)), o[et][4 * i4 + 1] * rl * silu_f(bfhi(gv.x)));
                wv.y = pk2(o[et][4 * i4 + 2] * rl * silu_f(bflo(gv.y)), o[et][4 * i4 + 3] * rl * silu_f(bfhi(gv.y)));
                if (!dry) *(u32x2*)(op + 32 * et + 8 * i4) = wv;
            }
    }
}

DI void dil_attn_item(LAS unsigned char* lds, bf16_t* qp, size_t ldq, const bf16_t* kp, const bf16_t* vp, float* lsep  , int i0, int tid, bool dry = false) {
    asm volatile("" : "+v"(tid)); __builtin_assume(tid >= 0 && tid < NT);
    const int lane = tid & 63, w = __builtin_amdgcn_readfirstlane(tid >> 6), h = lane >> 5, blk = (lane >> 4) & 1, q4 = (lane & 15) >> 2, p4 = lane & 3, ql = lane & 31;
    LAS unsigned char* Ks = lds;
    LAS unsigned char* Vs = lds;
    const int zr = (i0 == 0) ? 128 : 0;
    __syncthreads();
    load_rows<12, 16>(Ks, 272, kp - (ptrdiff_t)128 * 128, 128, zr, tid);
    bf16x8 qf[8];
    bf16_t* qrow = qp + (size_t)(32 * w + ql) * ldq;
#pragma unroll
    for (int ks = 0; ks < 8; ++ks) qf[ks] = *(const bf16x8*)(qrow + 16 * ks + 8 * h);
    __syncthreads();
    u32x4 vreg[12];
    ld_issue<12, 16>(vreg, vp - (ptrdiff_t)128 * 128, 128, zr, tid);
    __builtin_amdgcn_sched_barrier(0);
    f32x16 s[5];
#pragma unroll
    for (int kt = 0; kt < 5; ++kt) {
        s[kt] = zero16();
#pragma unroll
        for (int ks = 0; ks < 8; ++ks) { const bf16x8 a = *(const LAS bf16x8*)(Ks + (32 * w + 32 * kt + ql) * 272 + (16 * ks + 8 * h) * 2); s[kt] = MFMA32(a, qf[ks], s[kt]); }
    }
    const float c = 0.08838834764831845f * LOG2E;
    float m = -3.0e38f;
#pragma unroll
    for (int kt = 0; kt < 5; ++kt)
#pragma unroll
        for (int i = 0; i < 16; ++i) {
            const int kr = crow(i, h);
            bool valid = true;
            if (kt == 0) valid = (kr >= ql);
            if (kt == 4) valid = (kr <= ql);
            if (zr) valid = valid && (32 * w + 32 * kt + kr >= 128);
            s[kt][i] = valid ? s[kt][i] * c : -3.0e38f;
            m = fmaxf(m, s[kt][i]);
        }
    m = fmaxf(m, __shfl_xor(m, 32));
    float l = 0.f;
    bf16x8 pf[5][2];
#pragma unroll
    for (int kt = 0; kt < 5; ++kt) {
#pragma unroll
        for (int i = 0; i < 16; ++i) { s[kt][i] = __builtin_amdgcn_exp2f(s[kt][i] - m); l += s[kt][i]; }
        pf[kt][0] = pack8<0>(s[kt]); pf[kt][1] = pack8<1>(s[kt]);
        __builtin_amdgcn_sched_barrier(0);
    }
    l += __shfl_xor(l, 32);
    const float rl = 1.f / l;
    __syncthreads();
    ld_commit<12, 16>(Vs, 320, vreg, tid);
    __syncthreads();
    f32x16 o[4];
#pragma unroll
    for (int dt = 0; dt < 4; ++dt) {
        o[dt] = zero16();
#pragma unroll
        for (int kt = 0; kt < 5; ++kt)
#pragma unroll
            for (int sx = 0; sx < 2; ++sx) {
                const int r0 = 32 * w + 32 * kt + 16 * sx + 4 * h + q4; const int cb = (32 * dt + 16 * blk + 4 * p4) * 2;
                const bf16x8 a = tr_pair(Vs + r0 * 320 + cb, Vs + (r0 + 8) * 320 + cb);
                o[dt] = MFMA32(a, pf[kt][sx], o[dt]);
            }
    }
#pragma unroll
    for (int dt = 0; dt < 4; ++dt)
#pragma unroll
        for (int i4 = 0; i4 < 4; ++i4) {
            u32x2 wv; wv.x = pk2(o[dt][4 * i4] * rl, o[dt][4 * i4 + 1] * rl); wv.y = pk2(o[dt][4 * i4 + 2] * rl, o[dt][4 * i4 + 3] * rl);
            if (!dry) *(u32x2*)(qrow + 32 * dt + 8 * i4 + 4 * h) = wv;
        }
    if (h == 0 && !dry) lsep[(size_t)(32 * w + ql) * 16] = m * LN2 + __logf(l);
}

#define XB_TMO      128
#define XB_XCNT(j)  (256  + 64 * (j))
#define XB_XSUB(j)  (1280 + 64 * (j))
#define XB_XGEN(j)  (2304 + 64 * (j))
#define XB_TOP      3328
#define XB_TOPGEN   3392
#define XCD_BAR_WORDS 3456
#define XB_SPIN_CAP (1u << 18)

__device__ __forceinline__ unsigned xb_ld(unsigned* p)              { return __hip_atomic_load(p, __ATOMIC_RELAXED, __HIP_MEMORY_SCOPE_AGENT); }
__device__ __forceinline__ unsigned xb_add(unsigned* p, unsigned v) { return __hip_atomic_fetch_add(p, v, __ATOMIC_RELAXED, __HIP_MEMORY_SCOPE_AGENT); }
__device__ __forceinline__ unsigned xb_xcc_id() { return (unsigned)__builtin_amdgcn_s_getreg((3 << 11) | 20) & 0xFu; }
#define XB_SPIN(cond, bar) do { unsigned _sp = 0; while (cond) { __builtin_amdgcn_s_sleep(1); \
    if ((++_sp & 255u) == 0u) { if (xb_ld(&(bar)[XB_TMO])) break; if (_sp > XB_SPIN_CAP) { atomicAdd(&(bar)[XB_TMO], 1u); break; } } } } while (0)

struct XcdBarrier {
    unsigned* bar; unsigned x;
    volatile LAS unsigned* st;
};

__device__ __forceinline__ XcdBarrier xcd_barrier_post(unsigned* bar, volatile LAS unsigned* st) {
    XcdBarrier b; b.bar = bar; b.x = xb_xcc_id(); b.st = st;
    if (threadIdx.x == 0) (void)xb_add(&bar[XB_XCNT(b.x)], 1u);
    return b;
}
__device__ __forceinline__ void xcd_barrier_complete(unsigned* bar, unsigned x, unsigned& nloc, unsigned& nx) {
    const unsigned G = gridDim.x * gridDim.y * gridDim.z;
    unsigned sum, cnt, mine, sp = 0u;
    for (;;) {
        sum = 0u; cnt = 0u; mine = 0u;
#pragma unroll
        for (unsigned j = 0; j < 16; ++j) { const unsigned c = xb_ld(&bar[XB_XCNT(j)]); sum += c; cnt += (c > 0u) ? 1u : 0u; mine = (j == x) ? c : mine; }
        if (sum == G) break;
        __builtin_amdgcn_s_sleep(1);
        if ((++sp & 255u) == 0u) { if (xb_ld(&bar[XB_TMO])) break; if (sp > XB_SPIN_CAP) { atomicAdd(&bar[XB_TMO], 1u); break; } }
    }
    nloc = mine > 0u ? mine : 1u; nx = cnt > 0u ? cnt : 1u;
}

__device__ __forceinline__ void xcd_barrier(const XcdBarrier& b) {
    asm volatile("s_waitcnt vmcnt(0)" ::: "memory");
    __syncthreads();
    if (threadIdx.x == 0) {
        unsigned* bar = b.bar;
        __builtin_amdgcn_s_waitcnt(0);
        unsigned nloc = b.st[0], nx = b.st[1];
        if (nloc == 0u) { xcd_barrier_complete(bar, b.x, nloc, nx); b.st[0] = nloc; b.st[1] = nx; }
        const unsigned old = xb_add(&bar[XB_XSUB(b.x)], 1u);
        const unsigned gen = old / nloc;
        if (old + 1u == (gen + 1u) * nloc) {
            __builtin_amdgcn_fence(__ATOMIC_RELEASE, "agent");
            asm volatile("s_waitcnt vmcnt(0)" ::: "memory");
            const unsigned og = xb_add(&bar[XB_TOP], 1u);
            const unsigned tg = og / nx;
            if (og + 1u == (tg + 1u) * nx) xb_add(&bar[XB_TOPGEN], 1u);
            else XB_SPIN(xb_ld(&bar[XB_TOPGEN]) == tg, bar);
            __builtin_amdgcn_fence(__ATOMIC_ACQUIRE, "agent");
            xb_add(&bar[XB_XGEN(b.x)], 1u);
            asm volatile("s_waitcnt vmcnt(0)" ::: "memory");
        } else {
            XB_SPIN(xb_ld(&bar[XB_XGEN(b.x)]) == gen, bar);
            __builtin_amdgcn_fence(__ATOMIC_ACQUIRE, "agent");
            asm volatile("s_waitcnt vmcnt(0)" ::: "memory");
        }
    }
    __syncthreads();
}


struct Params {
    const float *x, *mem, *norm_a, *w_in_a, *w_out_a, *norm_b, *w_in_b, *w_out_b, *w_mem_kv, *mem_norm_g, *kv_norm_g, *w_kv, *final_norm_g;
    float* out; unsigned char* ws; int ph_lo, ph_hi;
};
enum { K_PRO = 0, K_A_GEMM, K_A_STATE, K_A_RETOUT, K_A_OUT, K_A_NORM, K_KV, K_B_NORM, K_B_GEMM, K_B_ATTN, K_B_MERGE, K_B_OUT, K_FINAL };

struct TrJob { const float* W; int K, N, nsrc0, ncols; bf16_t* WT; int drow0; };
DI bool tr_job(const Params& p, int kind, int la, int lb, int j, TrJob& t) {
    unsigned char* ws = p.ws;
    bf16_t* Win = (bf16_t*)(ws + WS_WIN); bf16_t* Wout = (bf16_t*)(ws + WS_WOUT);
    if (kind == K_PRO || (kind == K_A_NORM && la == 0)) {
        const int l = (kind == K_PRO) ? 0 : 1;
        if (j == 0) { t = TrJob{p.w_in_a + (size_t)l * 2048 * 8192, 2048, 8192, 0, 8192, Win, 0}; return true; }
        if (j == 1) { t = TrJob{p.w_out_a + (size_t)l * 3072 * 2048, 3072, 2048, 0, 2048, Wout, 0}; return true; }
        if (kind == K_PRO && j < 6) { t = TrJob{p.w_mem_kv + (size_t)(j - 2) * 2048 * 2048, 2048, 2048, 0, 2048, (bf16_t*)(ws + WS_WMEMT), (j - 2) * 2048}; return true; }
        return false;
    }
    if (kind == K_A_NORM) { if (j == 0) { t = TrJob{p.w_kv, 2048, 12288, 0, 12288, (bf16_t*)(ws + WS_WKVT), 0}; return true; } return false; }
    if (kind == K_B_NORM) {
        const float* wi = p.w_in_b + (size_t)lb * 2048 * 10240;
        switch (j) {
            case 0: t = TrJob{wi, 2048, 10240, 0, 2048, Win, 0}; return true;
            case 1: t = TrJob{wi, 2048, 10240, 8192, 1024, Win, 2048}; return true;
            case 2: t = TrJob{wi, 2048, 10240, 9216, 1024, Win, 3072}; return true;
            case 3: t = TrJob{wi, 2048, 10240, 6144, 2048, Win, 4096}; return true;
            case 4: t = TrJob{wi, 2048, 10240, 2048, 2048, Win, 6144}; return true;
            case 5: t = TrJob{wi, 2048, 10240, 4096, 2048, Win, 8192}; return true;
            case 6: t = TrJob{p.w_out_b + (size_t)lb * 3072 * 2048, 3072, 2048, 0, 2048, Wout, 0}; return true;
            default: return false;
        }
    }
    return false;
}
DI bool gemm_job(const Params& p, int kind, int la, int j, int G, int bid, pg8::Gemm& g, pg8::EpiBf16& E, int& c) {
    unsigned char* ws = p.ws; c = bid;
    bf16_t* Win = (bf16_t*)(ws + WS_WIN);
    if (kind == K_A_GEMM) {
        if (j == 0) { g = pg8::Gemm{(bf16_t*)(ws + WS_HA), Win, T_TOK, 8192, 2048, 2048, 1}; E = pg8::EpiBf16{(bf16_t*)(ws + WS_PROJA), 8192, 0, nullptr, 1}; return true; }
        if (j == 1 && la == 0) { g = pg8::Gemm{(bf16_t*)(ws + WS_MEMN), (bf16_t*)(ws + WS_WMEMT), 1024, 8192, 2048, 2048, 1}; E = pg8::EpiBf16{(bf16_t*)(ws + WS_MEMKV), 8192, 0, nullptr, 1}; c = (bid + G / 2) % G; return true; }
        return false;
    }
    if (kind == K_KV) {
        if (j >= 3) return false;
        const int dil = (j == 0) ? 1 : (j == 1 ? 4 : 16);
        g = pg8::Gemm{(bf16_t*)(ws + WS_HA), (bf16_t*)(ws + WS_WKVT) + (size_t)j * 4096 * 2048, T_TOK, 4096, 2048, 2048, dil};
        E = pg8::EpiBf16{(bf16_t*)(ws + WS_KV) + (size_t)j * T_TOK * 4096, 4096, 1, nullptr, dil}; return true;
    }
    if (kind == K_B_GEMM) {
        bf16_t* hB = (bf16_t*)(ws + WS_HB); bf16_t* projB = (bf16_t*)(ws + WS_P);
        if (j == 0) { g = pg8::Gemm{hB, Win, 8192, 6144, 2048, 2048, 1}; E = pg8::EpiBf16{projB, 10240, 0, nullptr, 1}; return true; }
        if (j == 1) { g = pg8::Gemm{hB, Win + (size_t)6144 * 2048, 8192, 2048, 2048, 2048, 4}; E = pg8::EpiBf16{projB + 6144, 10240, 0, nullptr, 4}; return true; }
        if (j == 2) { g = pg8::Gemm{hB, Win + (size_t)8192 * 2048, 8192, 2048, 2048, 2048, 16}; E = pg8::EpiBf16{projB + 8192, 10240, 0, nullptr, 16}; return true; }
        return false;
    }
    return false;
}

__global__ void __launch_bounds__(NT, 2) yoco_fwd(Params p) {
    extern __shared__ __attribute__((aligned(16))) unsigned char lds_raw[];
    LAS unsigned char* lds = (LAS unsigned char*)lds_raw;
    const int G = gridDim.x, bid = blockIdx.x;
    volatile LAS unsigned* bst = (volatile LAS unsigned*)(lds + LDS_BYTES - 16);
    if (threadIdx.x < 2) bst[threadIdx.x] = 0u;
    __syncthreads();
    XcdBarrier xbar = xcd_barrier_post((unsigned*)(p.ws + WS_BAR), bst);
#pragma unroll 1
    for (int ph = p.ph_lo; ph < p.ph_hi; ++ph) {
        int tid = threadIdx.x;
        asm volatile("" : "+v"(tid)); __builtin_assume(tid >= 0 && tid < NT);
        const int lane = tid & 63, wave = __builtin_amdgcn_readfirstlane(tid >> 6);
        const int gw = bid * 8 + wave, ngw = G * 8;
        unsigned char* ws = p.ws;
        int kind, la = 0, lb = 0, hb = 0;
        if (ph == 0) kind = K_PRO;
        else if (ph <= 10) { la = (ph - 1) / 5; kind = K_A_GEMM + (ph - 1) % 5; }
        else if (ph == 11) kind = K_KV;
        else if (ph <= 31) { const int idx = ph - 12; lb = idx / 10; hb = (idx / 5) % 2; kind = K_B_NORM + idx % 5; }
        else kind = K_FINAL;

        if (kind == K_PRO || kind == K_A_NORM || (kind == K_B_NORM && hb == 0)) {
            LAS float* scr = (LAS float*)(lds + wave * 16640);
            TrJob t;
#pragma unroll 1
            for (int j = 0; tr_job(p, kind, la, lb, j, t); ++j) transpose_seg(t.W, t.K, t.N, t.nsrc0, t.ncols, t.WT, t.drow0, scr, gw, ngw, lane);
        }
        if (kind == K_PRO || kind == K_A_NORM || kind == K_B_NORM) {
            if (kind == K_PRO) {
                norm_rows(p.mem, p.mem_norm_g, (bf16_t*)(ws + WS_MEMN), 1024, gw, ngw, lane);
                float* cosT = (float*)(ws + WS_COS); float* sinT = (float*)(ws + WS_SIN);
                for (int i = bid * NT + tid; i < 4096 * 64; i += G * NT) { const int pos = i >> 6, j = i & 63;
                    const float inv = 1.0f / powf(10000.0f, (float)j * (1.0f / 63.0f)); const float ang = (float)pos * inv;
                    cosT[i] = cosf(ang); sinT[i] = sinf(ang); }
            }
            const float* xin; const float* gg; bf16_t* ho; int nrows;
            if (kind == K_PRO) { xin = p.x; gg = p.norm_a; ho = (bf16_t*)(ws + WS_HA); nrows = T_TOK; }
            else if (kind == K_A_NORM) { xin = p.out; gg = (la == 0) ? p.norm_a + 2048 : p.kv_norm_g; ho = (bf16_t*)(ws + WS_HA); nrows = T_TOK; }
            else { xin = p.out + (size_t)hb * 8192 * DM; gg = p.norm_b + lb * 2048; ho = (bf16_t*)(ws + WS_HB); nrows = 8192; }
            norm_rows(xin, gg, ho, nrows, gw, ngw, lane);
        }
        if (kind == K_A_GEMM || kind == K_KV || kind == K_B_GEMM) {
            pg8::Gemm g; pg8::EpiBf16 E; int c;
#pragma unroll 1
            for (int rep = 0; rep < 1 + PROBE_GEMM; ++rep)
#pragma unroll 1
            for (int j = 0; gemm_job(p, kind, la, j, G, bid, g, E, c); ++j) { pg8::StaticOrder S; S.init(g.M, g.N, G, c); pg8::gemm_phase(lds, g, S, E); }
        }
        if (kind == K_A_OUT || kind == K_B_OUT) {
            pg8::Gemm g; pg8::EpiRes E;
            if (kind == K_A_OUT) { g = pg8::Gemm{(bf16_t*)(ws + WS_MIXA), (bf16_t*)(ws + WS_WOUT), T_TOK, 2048, 3072, 3072, 1}; E = pg8::EpiRes{la == 0 ? p.x : p.out, p.out}; }
            else { float* xh = p.out + (size_t)hb * 8192 * DM; g = pg8::Gemm{(bf16_t*)(ws + WS_P), (bf16_t*)(ws + WS_WOUT), 8192, 2048, 3072, 10240, 1}; E = pg8::EpiRes{xh, xh}; }
            pg8::StaticOrder S; S.init(g.M, g.N, G, bid); pg8::gemm_phase(lds, g, S, E);
        }
        if (kind == K_A_STATE) {
#pragma unroll 1
            for (int rep = 0; rep < 1 + PROBE_RET; ++rep)
#pragma unroll 1
            for (int it = bid; it < 128; it += G) { __syncthreads(); ret_state_item(lds, (bf16_t*)(ws + WS_PROJA), (bf16_t*)(ws + WS_RPREV), (float*)(ws + WS_COS), (float*)(ws + WS_SIN), it, tid); }
        }
        if (kind == K_B_ATTN) {
            bf16_t* projB = (bf16_t*)(ws + WS_P); float* lse = (float*)(ws + WS_LSE);
#pragma unroll 1
            for (int rep = 0; rep < 1 + PROBE_ATTN; ++rep)
#pragma unroll 1
            for (int it = bid; it < 1536; it += G) {
                const bool dry = PROBE_ATTN && (rep + p.ph_lo == 0);
                const int head = it & 15, blkr = (it >> 4) & 31, gi = it >> 9;
                const int n = (gi == 0) ? 4096 : (gi == 1 ? 1024 : 256);
                const int colq = (gi == 0) ? 0 : (gi == 1 ? 6144 : 8192);
                const int ml0 = blkr * 256, i0 = (ml0 & 4095) % n; const size_t mg0 = (size_t)hb * 8192 + ml0;
                const bf16_t* kvg = (bf16_t*)(ws + WS_KV) + (size_t)gi * T_TOK * 4096;
                dil_attn_item(lds, projB + (size_t)ml0 * 10240 + colq + head * 128, 10240, kvg + ((size_t)head * T_TOK + mg0) * 128, kvg + ((size_t)(16 + head) * T_TOK + mg0) * 128,
                              lse + ((size_t)gi * 8192 + ml0) * 16 + head, i0, tid, dry);
            }
        }
        if (kind == K_A_STATE || kind == K_B_ATTN) {
            const bool isA = (kind == K_A_STATE);
            const int nit = isA ? 256 : 128;
            const int first = (isA && G >= 256) ? 128 : 0;
            const bf16_t* memKV = (bf16_t*)(ws + WS_MEMKV);
            if (bid >= first) {
#pragma unroll 1
                for (int rep = 0; rep < 1 + (PROBE_ATTN | PROBE_RET); ++rep)
#pragma unroll 1
                for (int it = bid - first; it < nit; it += G - first) {
                    const bool dry = (PROBE_ATTN | PROBE_RET) && (rep + p.ph_lo == 0);
                    const int mh = it & 3, blkr = it >> 2; const size_t row0 = (size_t)blkr * 256;
                    const int b = isA ? (blkr >> 4) : (hb * 2 + (blkr >> 4)); const int layer = isA ? la : 2 + lb;
                    const bf16_t* km = memKV + (size_t)b * 256 * 8192 + layer * 2048 + mh * 256;
                    const bf16_t* qp; const bf16_t* gp; bf16_t* op; size_t ldq, ldo;
                    if (isA) { const bf16_t* pa = (bf16_t*)(ws + WS_PROJA) + row0 * 8192; qp = pa + 6144 + mh * 256; gp = pa + 7168 + mh * 256; ldq = 8192; op = (bf16_t*)(ws + WS_MIXA) + row0 * 3072 + 2048 + mh * 256; ldo = 3072; }
                    else { bf16_t* pb = (bf16_t*)(ws + WS_P) + row0 * 10240; qp = pb + 2048 + mh * 256; gp = pb + 3072 + mh * 256; ldq = 10240; op = pb + 2048 + mh * 256; ldo = 10240; }
                    mem_attn_item(lds, qp, ldq, gp, ldq, op, ldo, km, km + 1024, tid, dry);
                }
            }
        }
        if (kind == K_A_RETOUT) {
#pragma unroll 1
            for (int rep = 0; rep < 1 + PROBE_RET; ++rep)
#pragma unroll 1
            for (int it = bid; it < 1024; it += G) ret_out_item(lds, (bf16_t*)(ws + WS_PROJA), (bf16_t*)(ws + WS_RPREV), (bf16_t*)(ws + WS_MIXA), (float*)(ws + WS_COS), (float*)(ws + WS_SIN), it, tid);
        }
        if (kind == K_B_MERGE) {
            bf16_t* projB = (bf16_t*)(ws + WS_P); const float* lse = (const float*)(ws + WS_LSE);
#pragma unroll 1
            for (int rep = 0; rep < 1 + PROBE_ATTN; ++rep)
#pragma unroll 1
            for (int tl = gw; tl < 8192; tl += ngw) {
                const bool dry = PROBE_ATTN && (rep + p.ph_lo == 0);
                const int b = tl >> 12, ti = tl & 4095;
                const int m1 = b * 4096 + (ti & 3) * 1024 + (ti >> 2), m2 = b * 4096 + (ti & 15) * 256 + (ti >> 4);
                bf16_t* r0 = projB + (size_t)tl * 10240; const bf16_t* r1 = projB + (size_t)m1 * 10240 + 6144; const bf16_t* r2 = projB + (size_t)m2 * 10240 + 8192;
#pragma unroll
                for (int j = 0; j < 4; ++j) {
                    const int col = j * 512 + lane * 8, head = col >> 7;
                    const float l0 = lse[(size_t)tl * 16 + head], l1 = lse[((size_t)8192 + m1) * 16 + head], l2 = lse[((size_t)16384 + m2) * 16 + head];
                    const float mx = fmaxf(l0, fmaxf(l1, l2));
                    float a0 = __expf(l0 - mx), a1 = __expf(l1 - mx), a2 = __expf(l2 - mx); const float rs = 1.f / (a0 + a1 + a2); a0 *= rs; a1 *= rs; a2 *= rs;
                    const u32x4 v0 = *(const u32x4*)(r0 + col), v1 = *(const u32x4*)(r1 + col), v2 = *(const u32x4*)(r2 + col), gv = *(const u32x4*)(r0 + 4096 + col);
                    u32x4 ov;
#pragma unroll
                    for (int k = 0; k < 4; ++k) {
                        const float ea = a0 * bflo(v0[k]) + a1 * bflo(v1[k]) + a2 * bflo(v2[k]), eb = a0 * bfhi(v0[k]) + a1 * bfhi(v1[k]) + a2 * bfhi(v2[k]);
                        ov[k] = pk2(ea * silu_f(bflo(gv[k])), eb * silu_f(bfhi(gv[k])));
                    }
                    if (!dry) *(u32x4*)(r0 + col) = ov;
                }
            }
        }
        if (kind == K_FINAL) {
#pragma unroll 1
            for (int m = gw; m < T_TOK; m += ngw) {
                float* xr = p.out + (size_t)m * DM;
                f32x4 v[8]; float s = 0.f;
#pragma unroll
                for (int j = 0; j < 8; ++j) { v[j] = ((const f32x4*)xr)[lane + 64 * j]; s += (v[j].x * v[j].x + v[j].y * v[j].y) + (v[j].z * v[j].z + v[j].w * v[j].w); }
                const float rstd = rsqrtf(wave_sum(s) * (1.f / DM) + EPS);
#pragma unroll
                for (int j = 0; j < 8; ++j) { const f32x4 gg = ((const f32x4*)p.final_norm_g)[lane + 64 * j]; ((f32x4*)xr)[lane + 64 * j] = v[j] * rstd * gg; }
            }
        }
        if (ph + 1 < p.ph_hi) { if (ph == p.ph_lo) cg::this_grid().sync(); else xcd_barrier(xbar); }
    }
}

constexpr int N_PHASES = 1 + 2 * 5 + 1 + 4 * 5 + 1;

extern "C" void kernel_launch(void* const* d_in, const int* in_sizes, int n_in, void* d_out, int out_size, void* d_ws, size_t ws_size, hipStream_t stream) {
    static int grid = 0;
    if (grid == 0) {
        if (ws_size < WS_END) { fprintf(stderr, "kernel_launch: workspace too small: %zu < %zu\n", ws_size, (size_t)WS_END); grid = -1; return; }
        int dev = 0, cus = 0, per_cu = 0;
        hipGetDevice(&dev);
        hipDeviceGetAttribute(&cus, hipDeviceAttributeMultiprocessorCount, dev);
        if (hipFuncSetAttribute((const void*)yoco_fwd, hipFuncAttributeMaxDynamicSharedMemorySize, LDS_BYTES) != hipSuccess) { fprintf(stderr, "kernel_launch: hipFuncSetAttribute failed\n"); grid = -1; return; }
        if (hipOccupancyMaxActiveBlocksPerMultiprocessor(&per_cu, (const void*)yoco_fwd, NT, LDS_BYTES) != hipSuccess || per_cu < 1) { fprintf(stderr, "kernel_launch: occupancy query gave %d\n", per_cu); per_cu = 1; }
        (void)hipGetLastError();
        grid = cus;
        fprintf(stderr, "kernel_launch: grid %d (cus %d, per_cu %d), ws %zu\n", grid, cus, per_cu, ws_size);
    }
    if (grid < 0) return;
    (void)hipMemsetAsync((char*)d_ws + WS_BAR, 0, 16384, stream);
    Params p{};
    p.x = (const float*)d_in[0]; p.mem = (const float*)d_in[1]; p.norm_a = (const float*)d_in[2]; p.w_in_a = (const float*)d_in[3]; p.w_out_a = (const float*)d_in[4];
    p.norm_b = (const float*)d_in[5]; p.w_in_b = (const float*)d_in[6]; p.w_out_b = (const float*)d_in[7]; p.w_mem_kv = (const float*)d_in[8]; p.mem_norm_g = (const float*)d_in[9];
    p.kv_norm_g = (const float*)d_in[10]; p.w_kv = (const float*)d_in[11]; p.final_norm_g = (const float*)d_in[12];
    p.out = (float*)d_out; p.ws = (unsigned char*)d_ws;
#if MK_SPLIT
    for (int k = 0; k < N_PHASES; ++k) {
        p.ph_lo = k; p.ph_hi = k + 1;
        hipLaunchKernelGGL(yoco_fwd, dim3(grid), dim3(NT), LDS_BYTES, stream, p);
    }
#else
    p.ph_lo = 0; p.ph_hi = N_PHASES;
    void* args[] = {&p};
    hipError_t e = hipLaunchCooperativeKernel((const void*)yoco_fwd, dim3(grid), dim3(NT), args, LDS_BYTES, stream);
    if (e != hipSuccess) fprintf(stderr, "cooperative launch failed: %s (grid %d)\n", hipGetErrorString(e), grid);
#endif
}
```

```cpp
#include <hip/hip_runtime.h>
#include <hip/hip_cooperative_groups.h>
#include <cstdio>
#include <cstdint>
namespace cg = cooperative_groups;

#ifndef MK_SPLIT
#define MK_SPLIT 0
#endif

#ifndef PROBE_GEMM
#define PROBE_GEMM 0
#endif
#ifndef PROBE_RET
#define PROBE_RET 0
#endif
#ifndef PROBE_ATTN
#define PROBE_ATTN 0
#endif
#define LAS __attribute__((address_space(3)))
#define DI __device__ __forceinline__
typedef unsigned short bf16_t;
typedef short bf16x8 __attribute__((ext_vector_type(8)));
typedef short s16x4 __attribute__((ext_vector_type(4)));
typedef float f32x4 __attribute__((ext_vector_type(4)));
typedef float f32x16 __attribute__((ext_vector_type(16)));
typedef unsigned u32x4 __attribute__((ext_vector_type(4)));
typedef unsigned u32x2 __attribute__((ext_vector_type(2)));
typedef __bf16 nbf16x2 __attribute__((ext_vector_type(2)));

constexpr int NT = 512;
constexpr int T_TOK = 16384, DM = 2048, SEQ = 4096;
constexpr int LDS_BYTES = 144 * 1024;
constexpr float EPS = 1e-6f;
constexpr float LOG2E = 1.4426950408889634f, LN2 = 0.6931471805599453f;

constexpr size_t MiB = 1048576;
constexpr size_t WS_KV   = 0;
constexpr size_t WS_PROJA = 0;
constexpr size_t WS_MIXA = 256 * MiB;
constexpr size_t WS_WMEMT = 352 * MiB;
constexpr size_t WS_P    = 384 * MiB;
constexpr size_t WS_HA   = 384 * MiB;
constexpr size_t WS_RPREV = 448 * MiB;
constexpr size_t WS_WKVT = 448 * MiB;
constexpr size_t WS_MEMN = 512 * MiB;
constexpr size_t WS_HB   = 544 * MiB;
constexpr size_t WS_WIN  = 576 * MiB;
constexpr size_t WS_WOUT = 616 * MiB;
constexpr size_t WS_MEMKV = 628 * MiB;
constexpr size_t WS_COS  = 644 * MiB;
constexpr size_t WS_SIN  = 645 * MiB;
constexpr size_t WS_LSE  = 646 * MiB;
constexpr size_t WS_BAR  = 648 * MiB;
constexpr size_t WS_END  = 648 * MiB + 16384;

DI unsigned pk2(float a, float b) { nbf16x2 v; v[0] = (__bf16)a; v[1] = (__bf16)b; return __builtin_bit_cast(unsigned, v); }
DI float bflo(unsigned u) { return __uint_as_float(u << 16); }
DI float bfhi(unsigned u) { return __uint_as_float(u & 0xffff0000u); }
DI float silu_f(float x) { return x / (1.f + __expf(-x)); }
DI int crow(int i, int h) { return (i & 3) + 8 * (i >> 2) + 4 * h; }
DI float wave_sum(float v) {
#pragma unroll
    for (int o = 32; o >= 1; o >>= 1) v += __shfl_xor(v, o);
    return v;
}
#define MFMA32(a, b, c) __builtin_amdgcn_mfma_f32_32x32x16_bf16((a), (b), (c), 0, 0, 0)
template <int S> DI bf16x8 pack8(const f32x16& x) {
    u32x4 p; p[0] = pk2(x[8 * S], x[8 * S + 1]); p[1] = pk2(x[8 * S + 2], x[8 * S + 3]); p[2] = pk2(x[8 * S + 4], x[8 * S + 5]); p[3] = pk2(x[8 * S + 6], x[8 * S + 7]);
    return __builtin_bit_cast(bf16x8, p);
}
DI bf16x8 tr_pair(LAS unsigned char* lo_p, LAS unsigned char* hi_p) {
    s16x4 lo = __builtin_amdgcn_ds_read_tr16_b64_v4i16((LAS s16x4*)lo_p);
    s16x4 hi = __builtin_amdgcn_ds_read_tr16_b64_v4i16((LAS s16x4*)hi_p);
    return __builtin_shufflevector(lo, hi, 0, 1, 2, 3, 4, 5, 6, 7);
}
DI f32x16 zero16() { f32x16 z; for (int i = 0; i < 16; ++i) z[i] = 0.f; return z; }

namespace pg8 {
constexpr int BM = 256, BK = 64, HALF = 128, HTB = HALF * BK * 2, STAGE_BYTES = 8 * HTB, NXCD = 8, WGM = 8;
DI int lds_byte(int r, int c) { const int st = (r >> 4) * 2 + (c >> 5), rr = r & 15, cc = c & 31, ob = rr * 64 + cc * 2; return st * 1024 + (ob ^ (((ob >> 9) & 1) << 5)); }
DI void stage_rc(int b, int& R, int& C) { const int st = b / 1024, sb = b % 1024, swz = sb ^ (((sb >> 9) & 1) << 5); R = (st >> 1) * 16 + swz / 64; C = (st & 1) * 32 + (swz % 64) / 2; }
DI int perm32(int rho) { const int n = rho >> 4, i = rho & 15; return 8 * (i >> 2) + 4 * n + (i & 3); }
struct Unit { int pm, pn; };
struct Gemm { const bf16_t* A; const bf16_t* Bt; int M, N, K, lda, dil; };
struct StaticOrder {
    int nM, nN, nwg, G, c;
    DI void init(int M, int N, int G_, int c_) { nM = M / BM; nN = N / BM; nwg = nM * nN; G = G_; c = c_; }
    DI bool next(int i, Unit& u) const {
        const long L = (long)i * G + c; if (L >= nwg) return false;
        int wgid = (int)L; { const int q = nwg / NXCD, r = nwg % NXCD, xcd = wgid % NXCD, off = wgid / NXCD; wgid = (xcd < r ? xcd * (q + 1) : r * (q + 1) + (xcd - r) * q) + off; }
        const int nig = WGM * nN, gid = wgid / nig, fm = gid * WGM, gsz = (nM - fm) < WGM ? (nM - fm) : WGM;
        u.pm = fm + ((wgid % nig) % gsz); u.pn = (wgid % nig) / gsz; return true;
    }
};
DI size_t arow0(int pm, int dil) {
    const int m0 = pm * BM; if (dil == 1) return (size_t)m0;
    const int b = m0 >> 12, rem = m0 & 4095, n = 4096 / dil, r = rem / n, i0 = rem % n;
    return (size_t)(b * 4096 + i0 * dil + r);
}
struct EpiBf16 {
    static constexpr bool PERM = true;
    bf16_t* O; int ldc; int hm; const float* ss; int dil;
    DI void operator()(const f32x4 (&acc)[2][2][4][2], const Unit& u, int wr, int wc, int fr, int fq) const {
        const int row0 = u.pm * BM + wr * 64 + fr, col0 = u.pn * BM + wc * 32 + 8 * fq;
#pragma unroll
        for (int ai = 0; ai < 2; ++ai)
#pragma unroll
            for (int m = 0; m < 4; ++m) { const int row = row0 + ai * HALF + m * 16;
#pragma unroll
                for (int bj = 0; bj < 2; ++bj) { const f32x4 v0 = acc[ai][bj][m][0], v1 = acc[ai][bj][m][1];
                    u32x4 w; w.x = pk2(v0[0], v0[1]); w.y = pk2(v0[2], v0[3]); w.z = pk2(v1[0], v1[1]); w.w = pk2(v1[2], v1[3]);
                    const int col = col0 + bj * HALF;
                    bf16_t* dst = hm ? O + ((size_t)(col >> 7) * T_TOK + row) * 128 + (col & 127) : O + (size_t)row * ldc + col;
                    *(u32x4*)dst = w; } }
    }
};
struct EpiRes {
    static constexpr bool PERM = true;
    const float* xin; float* xout;
    DI void operator()(const f32x4 (&acc)[2][2][4][2], const Unit& u, int wr, int wc, int fr, int fq) const {
        const int row0 = u.pm * BM + wr * 64 + fr, col0 = u.pn * BM + wc * 32 + 8 * fq;
#pragma unroll
        for (int ai = 0; ai < 2; ++ai)
#pragma unroll
            for (int m = 0; m < 4; ++m) { const size_t off = (size_t)(row0 + ai * HALF + m * 16) * DM + col0;
                f32x4 b[2][2];
#pragma unroll
                for (int bj = 0; bj < 2; ++bj)
#pragma unroll
                    for (int n = 0; n < 2; ++n) b[bj][n] = *(const f32x4*)(xin + off + bj * HALF + n * 4);
#pragma unroll
                for (int bj = 0; bj < 2; ++bj)
#pragma unroll
                    for (int n = 0; n < 2; ++n) *(f32x4*)(xout + off + bj * HALF + n * 4) = b[bj][n] + acc[ai][bj][m][n]; }
    }
};

template <class Epi>
DI void gemm_phase(LAS unsigned char* lds, const Gemm g, const StaticOrder& S, const Epi& E) {
    int tid = threadIdx.x;
    asm volatile("" : "+v"(tid)); __builtin_assume(tid >= 0 && tid < NT);
    const int wid = __builtin_amdgcn_readfirstlane(tid >> 6), lane = tid & 63, wr = wid >> 2, wc = wid & 3, fr = lane & 15, fq = lane >> 4;
    const int K = g.K, nt = K / BK;
    unsigned voffA[2], voffB[2];
#pragma unroll
    for (int i = 0; i < 2; ++i) { int R, C; stage_rc(tid * 16 + i * 8192, R, C); const int Rb = Epi::PERM ? ((R & ~31) + perm32(R & 31)) : R;
        voffA[i] = (unsigned)(R * g.dil * g.lda + C) * 2u; voffB[i] = (unsigned)(Rb * K + C) * 2u; }
    const size_t kstep = (size_t)(BK * 2);
    const size_t hstepA = (size_t)HALF * g.dil * g.lda * 2, hstepB = (size_t)HALF * K * 2, tstepB = 2 * hstepB;
    const unsigned ldsw = (unsigned)wid * 1024u;
    const int aoff = lds_byte(wr * 64 + fr, fq * 8), boff = lds_byte(wc * 32 + fr, fq * 8);
#define PG8_SA(b, h) (((b) * 2 + (h)) * HTB)
#define PG8_SB(b, h) ((4 + (b) * 2 + (h)) * HTB)
#define PG8_STAGE(bufoff, gbase, voff) do { _Pragma("unroll") for (int _i = 0; _i < 2; ++_i) \
        __builtin_amdgcn_global_load_lds((const unsigned*)((const char*)(gbase) + (voff)[_i]), (LAS unsigned*)(lds + (bufoff) + ldsw + _i * 8192), 16, 0, 0); } while (0)
#define PG8_LDA(dst, b, h) do { _Pragma("unroll") for (int m = 0; m < 4; ++m) _Pragma("unroll") for (int k = 0; k < 2; ++k) dst[m][k] = *(const LAS bf16x8*)(lds + PG8_SA(b, h) + aoff + m * 2048 + k * 1024); } while (0)
#define PG8_LDB(dst, b, h) do { _Pragma("unroll") for (int n = 0; n < 2; ++n) _Pragma("unroll") for (int k = 0; k < 2; ++k) dst[n][k] = *(const LAS bf16x8*)(lds + PG8_SB(b, h) + boff + n * 2048 + k * 1024); } while (0)
#define PG8_MMA(ai, bj, At, Bt) do { __builtin_amdgcn_s_setprio(1); _Pragma("unroll") for (int m = 0; m < 4; ++m) _Pragma("unroll") for (int n = 0; n < 2; ++n) _Pragma("unroll") for (int k = 0; k < 2; ++k) \
        acc[ai][bj][m][n] = __builtin_amdgcn_mfma_f32_16x16x32_bf16(Bt[n][k], At[m][k], acc[ai][bj][m][n], 0, 0, 0); __builtin_amdgcn_s_setprio(0); } while (0)
#define PG8_WAIT_V(n) asm volatile("s_waitcnt vmcnt(" #n ")" ::: "memory")
#define PG8_WAIT_L(n) asm volatile("s_waitcnt lgkmcnt(" #n ")" ::: "memory")
#define PG8_BAR __builtin_amdgcn_s_barrier()
#define PG8_SCHED __builtin_amdgcn_sched_barrier(0)
    Unit cur, nxt; int ui = 0;
    if (!S.next(0, cur)) return;
    f32x4 acc[2][2][4][2];
#pragma unroll
    for (int a = 0; a < 2; ++a)
#pragma unroll
        for (int b = 0; b < 2; ++b)
#pragma unroll
            for (int m = 0; m < 4; ++m)
#pragma unroll
                for (int n = 0; n < 2; ++n) acc[a][b][m][n] = (f32x4){0.f, 0.f, 0.f, 0.f};
    bf16x8 At[4][2], B0[2][2], B1[2][2];
    const char* cA = (const char*)g.A + arow0(cur.pm, g.dil) * (size_t)g.lda * 2; const char* cB = (const char*)g.Bt + (size_t)cur.pn * tstepB;
    PG8_STAGE(PG8_SB(0, 0), cB, voffB); PG8_STAGE(PG8_SB(0, 1), cB + hstepB, voffB); PG8_STAGE(PG8_SA(0, 0), cA, voffA); PG8_STAGE(PG8_SA(0, 1), cA + hstepA, voffA);
    if (wr == 1) PG8_BAR;
    PG8_WAIT_V(2); PG8_BAR;
    PG8_STAGE(PG8_SB(1, 0), cB + kstep, voffB); PG8_STAGE(PG8_SA(1, 0), cA + kstep, voffA); PG8_STAGE(PG8_SB(1, 1), cB + hstepB + kstep, voffB);
    PG8_WAIT_V(6); PG8_BAR;
    for (;;) {
        const bool has_next = S.next(ui + 1, nxt);
        const char* nA = has_next ? (const char*)g.A + arow0(nxt.pm, g.dil) * (size_t)g.lda * 2 : cA; const char* nB = has_next ? (const char*)g.Bt + (size_t)nxt.pn * tstepB : cB;
        for (int t = 0; t < nt; t += 2) {
            const bool last = (t == nt - 2);
            const char* a1 = cA + (size_t)(t + 1) * kstep;
            const char* a2 = last ? nA : cA + (size_t)(t + 2) * kstep; const char* b2 = last ? nB : cB + (size_t)(t + 2) * kstep;
            const char* a3 = a2 + kstep; const char* b3 = b2 + kstep;
            PG8_LDB(B0, 0, 0); PG8_LDB(B1, 0, 1); PG8_SCHED; PG8_LDA(At, 0, 0); PG8_STAGE(PG8_SA(1, 1), a1 + hstepA, voffA);
            PG8_WAIT_V(8); PG8_WAIT_L(0); PG8_BAR; PG8_MMA(0, 0, At, B0); PG8_MMA(0, 1, At, B1); PG8_BAR; PG8_SCHED;
            PG8_LDA(At, 0, 1); PG8_STAGE(PG8_SB(0, 0), b2, voffB); PG8_STAGE(PG8_SB(0, 1), b2 + hstepB, voffB); PG8_STAGE(PG8_SA(0, 0), a2, voffA);
            PG8_WAIT_V(8); PG8_WAIT_L(0); PG8_BAR; PG8_MMA(1, 0, At, B0); PG8_MMA(1, 1, At, B1); PG8_BAR; PG8_SCHED;
            PG8_LDB(B0, 1, 0); PG8_LDB(B1, 1, 1); PG8_SCHED; PG8_LDA(At, 1, 0); PG8_STAGE(PG8_SA(0, 1), a2 + hstepA, voffA);
            PG8_WAIT_V(8); PG8_WAIT_L(0); PG8_BAR; PG8_MMA(0, 0, At, B0); PG8_MMA(0, 1, At, B1); PG8_BAR; PG8_SCHED;
            PG8_LDA(At, 1, 1); PG8_STAGE(PG8_SB(1, 0), b3, voffB); PG8_STAGE(PG8_SB(1, 1), b3 + hstepB, voffB); PG8_STAGE(PG8_SA(1, 0), a3, voffA);
            PG8_WAIT_V(8); PG8_WAIT_L(0); PG8_BAR; PG8_MMA(1, 0, At, B0); PG8_MMA(1, 1, At, B1); PG8_BAR; PG8_SCHED;
        }
        if (wr == 0) PG8_BAR;
        E(acc, cur, wr, wc, fr, fq);
        if (!has_next) break;
#pragma unroll
        for (int a = 0; a < 2; ++a)
#pragma unroll
            for (int b = 0; b < 2; ++b)
#pragma unroll
                for (int m = 0; m < 4; ++m)
#pragma unroll
                    for (int n = 0; n < 2; ++n) acc[a][b][m][n] = (f32x4){0.f, 0.f, 0.f, 0.f};
        cur = nxt; cA = nA; cB = nB; ++ui;
        if (wr == 1) PG8_BAR;
    }
    PG8_WAIT_V(0);
    PG8_BAR;
#undef PG8_SA
#undef PG8_SB
#undef PG8_STAGE
#undef PG8_LDA
#undef PG8_LDB
#undef PG8_MMA
#undef PG8_WAIT_V
#undef PG8_WAIT_L
#undef PG8_BAR
#undef PG8_SCHED
}
}

template <int NCH, int CPR>
DI void load_rows(LAS unsigned char* dst, int dstride, const bf16_t* src, size_t ld, int zrows, int tid) {
    u32x4 v[NCH];
#pragma unroll
    for (int j = 0; j < NCH; ++j) { const int c = tid + NT * j, row = c / CPR, ch = c % CPR;
        v[j] = (u32x4){0u, 0u, 0u, 0u};
        if (row >= zrows) v[j] = *(const u32x4*)(src + (ptrdiff_t)row * (ptrdiff_t)ld + ch * 8); }
#pragma unroll
    for (int j = 0; j < NCH; ++j) { const int c = tid + NT * j, row = c / CPR, ch = c % CPR;
        *(LAS u32x4*)(dst + row * dstride + ch * 16) = v[j]; }
}
template <int NCH, int CPR>
DI void ld_issue(u32x4 (&v)[NCH], const bf16_t* src, size_t ld, int zrows, int tid) {
#pragma unroll
    for (int j = 0; j < NCH; ++j) { const int c = tid + NT * j, row = c / CPR, ch = c % CPR;
        v[j] = (u32x4){0u, 0u, 0u, 0u};
        if (row >= zrows) v[j] = *(const u32x4*)(src + (ptrdiff_t)row * (ptrdiff_t)ld + ch * 8); }
}
template <int NCH, int CPR>
DI void ld_commit(LAS unsigned char* dst, int dstride, const u32x4 (&v)[NCH], int tid) {
#pragma unroll
    for (int j = 0; j < NCH; ++j) { const int c = tid + NT * j, row = c / CPR, ch = c % CPR;
        *(LAS u32x4*)(dst + row * dstride + ch * 16) = v[j]; }
}
template <bool ZETA>
DI void load_rot(LAS unsigned char* dst, int dstride, const bf16_t* src, size_t ld, const float* cosT, const float* sinT, int pos0, float scale, float log2g, int tid) {
#pragma unroll
    for (int j = 0; j < 2; ++j) {
        const int c = tid + NT * j, row = c >> 3, ch = c & 7;
        const bf16_t* p = src + (size_t)row * ld + ch * 8;
        const u32x4 a = *(const u32x4*)p, b = *(const u32x4*)(p + 64);
        const float* cp = cosT + (size_t)(pos0 + row) * 64 + ch * 8; const float* sp = sinT + (size_t)(pos0 + row) * 64 + ch * 8;
        const f32x4 c0 = *(const f32x4*)cp, c1 = *(const f32x4*)(cp + 4), s0 = *(const f32x4*)sp, s1 = *(const f32x4*)(sp + 4);
        float f = scale; if (ZETA) f *= exp2f((float)(127 - row) * log2g);
        u32x4 o1, o2;
#pragma unroll
        for (int k = 0; k < 4; ++k) {
            const float x1a = bflo(a[k]), x1b = bfhi(a[k]), x2a = bflo(b[k]), x2b = bfhi(b[k]);
            const float ca = (k < 2) ? c0[2 * k] : c1[2 * k - 4], cb = (k < 2) ? c0[2 * k + 1] : c1[2 * k - 3];
            const float sa = (k < 2) ? s0[2 * k] : s1[2 * k - 4], sb = (k < 2) ? s0[2 * k + 1] : s1[2 * k - 3];
            o1[k] = pk2((x1a * ca - x2a * sa) * f, (x1b * cb - x2b * sb) * f);
            o2[k] = pk2((x1a * sa + x2a * ca) * f, (x1b * sb + x2b * cb) * f);
        }
        *(LAS u32x4*)(dst + row * dstride + ch * 16) = o1;
        *(LAS u32x4*)(dst + row * dstride + 128 + ch * 16) = o2;
    }
}

DI void transpose_seg(const float* W, int K, int N, int nsrc0, int ncols, bf16_t* WT, int drow0, LAS float* scr, int gw, int ngw, int lane) {
    const int nblk = ncols / 64, nitems = (K / 64) * nblk;
    const int kk4 = lane >> 4, c4 = (lane & 15) * 4, c = lane & 7, n8 = lane >> 3;
    for (int item = gw; item < nitems; item += ngw) {
        const int kb = item / nblk, nb = item % nblk, k0 = 64 * kb, n0 = 64 * nb;
        const float* src = W + (size_t)(k0 + kk4) * N + nsrc0 + n0 + c4;
        f32x4 v[16];
#pragma unroll
        for (int i = 0; i < 16; ++i) v[i] = *(const f32x4*)(src + (size_t)(4 * i) * N);
#pragma unroll
        for (int i = 0; i < 16; ++i) { LAS float* d = scr + (4 * i + kk4) * 65 + c4; d[0] = v[i].x; d[1] = v[i].y; d[2] = v[i].z; d[3] = v[i].w; }
        asm volatile("s_waitcnt lgkmcnt(0)" ::: "memory");
#pragma unroll
        for (int j = 0; j < 8; ++j) { const int n = n8 + 8 * j; const LAS float* s = scr + (8 * c) * 65 + n;
            u32x4 o; o.x = pk2(s[0 * 65], s[1 * 65]); o.y = pk2(s[2 * 65], s[3 * 65]); o.z = pk2(s[4 * 65], s[5 * 65]); o.w = pk2(s[6 * 65], s[7 * 65]);
            *(u32x4*)(WT + (size_t)(drow0 + n0 + n) * K + k0 + 8 * c) = o; }
        asm volatile("s_waitcnt lgkmcnt(0)" ::: "memory");
    }
}
DI void norm_row_bf16(const float* xr, const float* g, bf16_t* o, int lane) {
    f32x4 v[8]; float s = 0.f;
#pragma unroll
    for (int j = 0; j < 8; ++j) { v[j] = ((const f32x4*)xr)[lane + 64 * j]; s += (v[j].x * v[j].x + v[j].y * v[j].y) + (v[j].z * v[j].z + v[j].w * v[j].w); }
    const float rstd = rsqrtf(wave_sum(s) * (1.f / DM) + EPS);
#pragma unroll
    for (int j = 0; j < 8; ++j) { const f32x4 gg = ((const f32x4*)g)[lane + 64 * j];
        u32x2 w; w.x = pk2(v[j].x * rstd * gg.x, v[j].y * rstd * gg.y); w.y = pk2(v[j].z * rstd * gg.z, v[j].w * rstd * gg.w);
        ((u32x2*)o)[lane + 64 * j] = w; }
}
DI void norm_rows(const float* x, const float* g, bf16_t* o, int nrows, int gw, int ngw, int lane) {
    for (int m = gw; m < nrows; m += ngw) norm_row_bf16(x + (size_t)m * DM, g, o + (size_t)m * DM, lane);
}

struct StRaw { u32x4 ka[2], kb[2], vv[2]; f32x4 c0[2], c1[2], s0[2], s1[2]; };
DI void st_issue(StRaw& r, const bf16_t* projA, const float* cosT, const float* sinT, int b, int hh, int es, int n, int tid) {
    const size_t row0 = (size_t)b * SEQ + n * 128;
#pragma unroll
    for (int j = 0; j < 2; ++j) {
        const int c = tid + NT * j, row = c >> 3, ch = c & 7;
        const bf16_t* p = projA + (row0 + row) * 8192 + 1024 + hh * 128 + ch * 8;
        r.ka[j] = *(const u32x4*)p; r.kb[j] = *(const u32x4*)(p + 64);
        const float* cp = cosT + (size_t)(n * 128 + row) * 64 + ch * 8; const float* sp = sinT + (size_t)(n * 128 + row) * 64 + ch * 8;
        r.c0[j] = *(const f32x4*)cp; r.c1[j] = *(const f32x4*)(cp + 4); r.s0[j] = *(const f32x4*)sp; r.s1[j] = *(const f32x4*)(sp + 4);
        r.vv[j] = *(const u32x4*)(projA + (row0 + row) * 8192 + 2048 + hh * 256 + 64 * es + ch * 8);
    }
}
DI void st_commit(const StRaw& r, LAS unsigned char* Kz, LAS unsigned char* Vz, float log2g, int tid) {
#pragma unroll
    for (int j = 0; j < 2; ++j) {
        const int c = tid + NT * j, row = c >> 3, ch = c & 7;
        const float f = 0.08838834764831845f * exp2f((float)(127 - row) * log2g);
        const u32x4 a = r.ka[j], b = r.kb[j]; const f32x4 c0 = r.c0[j], c1 = r.c1[j], s0 = r.s0[j], s1 = r.s1[j];
        u32x4 o1, o2;
#pragma unroll
        for (int k = 0; k < 4; ++k) {
            const float x1a = bflo(a[k]), x1b = bfhi(a[k]), x2a = bflo(b[k]), x2b = bfhi(b[k]);
            const float ca = (k < 2) ? c0[2 * k] : c1[2 * k - 4], cb = (k < 2) ? c0[2 * k + 1] : c1[2 * k - 3];
            const float sa = (k < 2) ? s0[2 * k] : s1[2 * k - 4], sb = (k < 2) ? s0[2 * k + 1] : s1[2 * k - 3];
            o1[k] = pk2((x1a * ca - x2a * sa) * f, (x1b * cb - x2b * sb) * f);
            o2[k] = pk2((x1a * sa + x2a * ca) * f, (x1b * sb + x2b * cb) * f);
        }
        *(LAS u32x4*)(Kz + row * 320 + ch * 16) = o1;
        *(LAS u32x4*)(Kz + row * 320 + 128 + ch * 16) = o2;
        *(LAS u32x4*)(Vz + row * 192 + ch * 16) = r.vv[j];
    }
}
DI void ret_state_item(LAS unsigned char* lds, const bf16_t* projA, bf16_t* rprev, const float* cosT, const float* sinT, int item, int tid) {
    asm volatile("" : "+v"(tid)); __builtin_assume(tid >= 0 && tid < NT);
    const int lane = tid & 63, w = __builtin_amdgcn_readfirstlane(tid >> 6), h = lane >> 5, blk = (lane >> 4) & 1, q4 = (lane & 15) >> 2, p4 = lane & 3;
    const int es = item & 3, hh = (item >> 2) & 7, b = item >> 5;
    const int et = w & 1, dt = w >> 1;
    const float log2g = log2f(1.f - exp2f(-5.f - (float)hh));
    const float gchunk = exp2f(128.f * log2g);
    f32x16 acc = zero16();
    StRaw raw;
    st_issue(raw, projA, cosT, sinT, b, hh, es, 0, tid);
#pragma unroll 1
    for (int n = 0; n < 32; ++n) {
        bf16_t* rp = rprev + ((size_t)((b * 8 + hh) * 32 + n) * 256 + 64 * es + 32 * et) * 128 + 32 * dt + (lane & 31);
#pragma unroll
        for (int i = 0; i < 16; ++i) rp[(size_t)crow(i, h) * 128] = (bf16_t)(pk2(acc[i], 0.f) & 0xffffu);
        if (n == 31) break;
        LAS unsigned char* Kz = lds + (n & 1) * 65536;
        LAS unsigned char* Vz = Kz + 128 * 320;
        st_commit(raw, Kz, Vz, log2g, tid);
        if (n < 30) st_issue(raw, projA, cosT, sinT, b, hh, es, n + 1, tid);
        __syncthreads();
#pragma unroll
        for (int i = 0; i < 16; ++i) acc[i] *= gchunk;
#pragma unroll
        for (int ks = 0; ks < 8; ++ks) {
            const int r0 = 16 * ks + 8 * h + q4;
            const bf16x8 a = tr_pair(Vz + r0 * 192 + (32 * et + 16 * blk + 4 * p4) * 2, Vz + (r0 + 4) * 192 + (32 * et + 16 * blk + 4 * p4) * 2);
            const bf16x8 bb = tr_pair(Kz + r0 * 320 + (32 * dt + 16 * blk + 4 * p4) * 2, Kz + (r0 + 4) * 320 + (32 * dt + 16 * blk + 4 * p4) * 2);
            acc = MFMA32(a, bb, acc);
        }
    }
    __syncthreads();
}

DI void ret_out_item(LAS unsigned char* lds, const bf16_t* projA, const bf16_t* rprev, bf16_t* mix, const float* cosT, const float* sinT, int item, int tid) {
    asm volatile("" : "+v"(tid)); __builtin_assume(tid >= 0 && tid < NT);
    const int lane = tid & 63, w = __builtin_amdgcn_readfirstlane(tid >> 6), h = lane >> 5, blk = (lane >> 4) & 1, q4 = (lane & 15) >> 2, p4 = lane & 3, ql = lane & 31;
    const int n = item & 31, hh = (item >> 5) & 7, b = item >> 8;
    const int qsub = w & 3, eh = w >> 2;
    const float log2g = log2f(1.f - exp2f(-5.f - (float)hh));
    LAS unsigned char* Qs = lds;
    LAS unsigned char* Ks = lds + 34816;
    LAS unsigned char* Rs = lds + 69632;
    LAS unsigned char* Vs = lds;
    LAS float* red = (LAS float*)(lds + 139264);
    const size_t row0 = (size_t)b * SEQ + n * 128;
    __syncthreads();
    load_rot<false>(Qs, 272, projA + row0 * 8192 + hh * 128, 8192, cosT, sinT, n * 128, 1.f, 0.f, tid);
    load_rot<false>(Ks, 272, projA + row0 * 8192 + 1024 + hh * 128, 8192, cosT, sinT, n * 128, 0.08838834764831845f, 0.f, tid);
    load_rows<8, 16>(Rs, 272, rprev + (size_t)((b * 8 + hh) * 32 + n) * 256 * 128, 128, 0, tid);
    __syncthreads();
    bf16x8 qf[8];
#pragma unroll
    for (int ks = 0; ks < 8; ++ks) qf[ks] = *(const LAS bf16x8*)(Qs + (32 * qsub + ql) * 272 + (16 * ks + 8 * h) * 2);
    bf16x8 pf[4][2];
#pragma unroll
    for (int kt = 0; kt < 4; ++kt) {
        if (kt <= qsub) {
            f32x16 s = zero16();
#pragma unroll
            for (int ks = 0; ks < 8; ++ks) { const bf16x8 a = *(const LAS bf16x8*)(Ks + (32 * kt + ql) * 272 + (16 * ks + 8 * h) * 2); s = MFMA32(a, qf[ks], s); }
#pragma unroll
            for (int i = 0; i < 16; ++i) { const int dq = (32 * qsub + ql) - (32 * kt + crow(i, h)); s[i] = (dq >= 0) ? s[i] * __builtin_amdgcn_exp2f((float)dq * log2g) : 0.f; }
            pf[kt][0] = pack8<0>(s); pf[kt][1] = pack8<1>(s);
            __builtin_amdgcn_sched_barrier(0);
        } else { pf[kt][0] = (bf16x8){0, 0, 0, 0, 0, 0, 0, 0}; pf[kt][1] = pf[kt][0]; }
    }
    f32x16 o[4];
    const float xi = exp2f((float)(32 * qsub + ql + 1) * log2g);
#pragma unroll
    for (int et = 0; et < 4; ++et) {
        o[et] = zero16();
#pragma unroll
        for (int ks = 0; ks < 8; ++ks) { const bf16x8 a = *(const LAS bf16x8*)(Rs + (128 * eh + 32 * et + ql) * 272 + (16 * ks + 8 * h) * 2); o[et] = MFMA32(a, qf[ks], o[et]); }
#pragma unroll
        for (int i = 0; i < 16; ++i) o[et][i] *= xi;
    }
    __syncthreads();
    load_rows<8, 32>(Vs, 576, projA + row0 * 8192 + 2048 + hh * 256, 8192, 0, tid);
    __syncthreads();
#pragma unroll
    for (int et = 0; et < 4; ++et)
#pragma unroll
        for (int kt = 0; kt < 4; ++kt)
            if (kt <= qsub) {
#pragma unroll
                for (int s = 0; s < 2; ++s) {
                    const int r0 = 32 * kt + 16 * s + 4 * h + q4; const int cb = (128 * eh + 32 * et + 16 * blk + 4 * p4) * 2;
                    const bf16x8 a = tr_pair(Vs + r0 * 576 + cb, Vs + (r0 + 8) * 576 + cb);
                    o[et] = MFMA32(a, pf[kt][s], o[et]);
                }
            }
    float ss = 0.f;
#pragma unroll
    for (int et = 0; et < 4; ++et)
#pragma unroll
        for (int i = 0; i < 16; ++i) ss += o[et][i] * o[et][i];
    ss += __shfl_xor(ss, 32);
    if (h == 0) red[eh * 128 + 32 * qsub + ql] = ss;
    __syncthreads();
    const float tot = red[32 * qsub + ql] + red[128 + 32 * qsub + ql];
    const float rstd = rsqrtf(tot * (1.f / 256.f) + EPS);
    const size_t tok = row0 + 32 * qsub + ql;
    const bf16_t* gp = projA + tok * 8192 + 4096 + hh * 256 + 128 * eh + 4 * h;
    bf16_t* op = mix + tok * 3072 + hh * 256 + 128 * eh + 4 * h;
#pragma unroll
    for (int et = 0; et < 4; ++et)
#pragma unroll
        for (int i4 = 0; i4 < 4; ++i4) {
            const u32x2 gv = *(const u32x2*)(gp + 32 * et + 8 * i4);
            u32x2 wv;
            wv.x = pk2(o[et][4 * i4] * rstd * silu_f(bflo(gv.x)), o[et][4 * i4 + 1] * rstd * silu_f(bfhi(gv.x)));
            wv.y = pk2(o[et][4 * i4 + 2] * rstd * silu_f(bflo(gv.y)), o[et][4 * i4 + 3] * rstd * silu_f(bfhi(gv.y)));
            *(u32x2*)(op + 32 * et + 8 * i4) = wv;
        }
}

DI void mem_attn_item(LAS unsigned char* lds, const bf16_t* qp, size_t ldq, const bf16_t* gatep, size_t ldg, bf16_t* outp, size_t ldo,
                      const bf16_t* kmem, const bf16_t* vmem, int tid, bool dry = false) {
    asm volatile("" : "+v"(tid)); __builtin_assume(tid >= 0 && tid < NT);
    const int lane = tid & 63, w = __builtin_amdgcn_readfirstlane(tid >> 6), h = lane >> 5, blk = (lane >> 4) & 1, q4 = (lane & 15) >> 2, p4 = lane & 3, ql = lane & 31;
    LAS unsigned char* Ks = lds;
    LAS unsigned char* Vs = lds;
    __syncthreads();
    load_rows<16, 32>(Ks, 528, kmem, 8192, 0, tid);
    __syncthreads();
    const bf16_t* qrow = qp + (size_t)(32 * w + ql) * ldq + 8 * h;
    f32x16 s[8];
#pragma unroll
    for (int kt = 0; kt < 8; ++kt) s[kt] = zero16();
#pragma unroll
    for (int dh = 0; dh < 2; ++dh) {
        bf16x8 qf[8];
#pragma unroll
        for (int ks = 0; ks < 8; ++ks) qf[ks] = *(const bf16x8*)(qrow + 128 * dh + 16 * ks);
#pragma unroll
        for (int kt = 0; kt < 8; ++kt)
#pragma unroll
            for (int ks = 0; ks < 8; ++ks) { const bf16x8 a = *(const LAS bf16x8*)(Ks + (32 * kt + ql) * 528 + (128 * dh + 16 * ks + 8 * h) * 2); s[kt] = MFMA32(a, qf[ks], s[kt]); }
    }
    const float c = 0.0625f * LOG2E;
    float m = -3.0e38f;
#pragma unroll
    for (int kt = 0; kt < 8; ++kt)
#pragma unroll
        for (int i = 0; i < 16; ++i) { s[kt][i] *= c; m = fmaxf(m, s[kt][i]); }
    m = fmaxf(m, __shfl_xor(m, 32));
    float l = 0.f;
    bf16x8 pf[8][2];
#pragma unroll
    for (int kt = 0; kt < 8; ++kt) {
#pragma unroll
        for (int i = 0; i < 16; ++i) { s[kt][i] = __builtin_amdgcn_exp2f(s[kt][i] - m); l += s[kt][i]; }
        pf[kt][0] = pack8<0>(s[kt]); pf[kt][1] = pack8<1>(s[kt]);
        __builtin_amdgcn_sched_barrier(0);
    }
    l += __shfl_xor(l, 32);
    const float rl = 1.f / l;
#pragma unroll
    for (int eh = 0; eh < 2; ++eh) {
        __syncthreads();
        load_rows<8, 16>(Vs, 320, vmem + 128 * eh, 8192, 0, tid);
        __syncthreads();
        f32x16 o[4];
#pragma unroll
        for (int et = 0; et < 4; ++et) {
            o[et] = zero16();
#pragma unroll
            for (int kt = 0; kt < 8; ++kt)
#pragma unroll
                for (int sx = 0; sx < 2; ++sx) {
                    const int r0 = 32 * kt + 16 * sx + 4 * h + q4; const int cb = (32 * et + 16 * blk + 4 * p4) * 2;
                    const bf16x8 a = tr_pair(Vs + r0 * 320 + cb, Vs + (r0 + 8) * 320 + cb);
                    o[et] = MFMA32(a, pf[kt][sx], o[et]);
                }
        }
        const bf16_t* gp = gatep + (size_t)(32 * w + ql) * ldg + 128 * eh + 4 * h;
        bf16_t* op = outp + (size_t)(32 * w + ql) * ldo + 128 * eh + 4 * h;
#pragma unroll
        for (int et = 0; et < 4; ++et)
#pragma unroll
            for (int i4 = 0; i4 < 4; ++i4) {
                const u32x2 gv = *(const u32x2*)(gp + 32 * et + 8 * i4);
                u32x2 wv;
                wv.x = pk2(o[et][4 * i4] * rl * silu_f(bflo(gv.x)), o[et][4 * i4 + 1] * rl * silu_f(bfhi(gv.x)));
                wv.y = pk2(o[et][4 * i4 + 2] * rl * silu_f(bflo(gv.y)), o[et][4 * i4 + 3] * rl * silu_f(bfhi(gv.y)));
                if (!dry) *(u32x2*)(op + 32 * et + 8 * i4) = wv;
            }
    }
}

DI void dil_attn_item(LAS unsigned char* lds, bf16_t* qp, size_t ldq, const bf16_t* kp, const bf16_t* vp, float* lsep  , int i0, int tid, bool dry = false) {
    asm volatile("" : "+v"(tid)); __builtin_assume(tid >= 0 && tid < NT);
    const int lane = tid & 63, w = __builtin_amdgcn_readfirstlane(tid >> 6), h = lane >> 5, blk = (lane >> 4) & 1, q4 = (lane & 15) >> 2, p4 = lane & 3, ql = lane & 31;
    LAS unsigned char* Ks = lds;
    LAS unsigned char* Vs = lds;
    const int zr = (i0 == 0) ? 128 : 0;
    __syncthreads();
    load_rows<12, 16>(Ks, 272, kp - (ptrdiff_t)128 * 128, 128, zr, tid);
    bf16x8 qf[8];
    bf16_t* qrow = qp + (size_t)(32 * w + ql) * ldq;
#pragma unroll
    for (int ks = 0; ks < 8; ++ks) qf[ks] = *(const bf16x8*)(qrow + 16 * ks + 8 * h);
    __syncthreads();
    u32x4 vreg[12];
    ld_issue<12, 16>(vreg, vp - (ptrdiff_t)128 * 128, 128, zr, tid);
    __builtin_amdgcn_sched_barrier(0);
    f32x16 s[5];
#pragma unroll
    for (int kt = 0; kt < 5; ++kt) {
        s[kt] = zero16();
#pragma unroll
        for (int ks = 0; ks < 8; ++ks) { const bf16x8 a = *(const LAS bf16x8*)(Ks + (32 * w + 32 * kt + ql) * 272 + (16 * ks + 8 * h) * 2); s[kt] = MFMA32(a, qf[ks], s[kt]); }
    }
    const float c = 0.08838834764831845f * LOG2E;
    float m = -3.0e38f;
#pragma unroll
    for (int kt = 0; kt < 5; ++kt)
#pragma unroll
        for (int i = 0; i < 16; ++i) {
            const int kr = crow(i, h);
            bool valid = true;
            if (kt == 0) valid = (kr >= ql);
            if (kt == 4) valid = (kr <= ql);
            if (zr) valid = valid && (32 * w + 32 * kt + kr >= 128);
            s[kt][i] = valid ? s[kt][i] * c : -3.0e38f;
            m = fmaxf(m, s[kt][i]);
        }
    m = fmaxf(m, __shfl_xor(m, 32));
    float l = 0.f;
    bf16x8 pf[5][2];
#pragma unroll
    for (int kt = 0; kt < 5; ++kt) {
#pragma unroll
        for (int i = 0; i < 16; ++i) { s[kt][i] = __builtin_amdgcn_exp2f(s[kt][i] - m); l += s[kt][i]; }
        pf[kt][0] = pack8<0>(s[kt]); pf[kt][1] = pack8<1>(s[kt]);
        __builtin_amdgcn_sched_barrier(0);
    }
    l += __shfl_xor(l, 32);
    const float rl = 1.f / l;
    __syncthreads();
    ld_commit<12, 16>(Vs, 320, vreg, tid);
    __syncthreads();
    f32x16 o[4];
#pragma unroll
    for (int dt = 0; dt < 4; ++dt) {
        o[dt] = zero16();
#pragma unroll
        for (int kt = 0; kt < 5; ++kt)
#pragma unroll
            for (int sx = 0; sx < 2; ++sx) {
                const int r0 = 32 * w + 32 * kt + 16 * sx + 4 * h + q4; const int cb = (32 * dt + 16 * blk + 4 * p4) * 2;
                const bf16x8 a = tr_pair(Vs + r0 * 320 + cb, Vs + (r0 + 8) * 320 + cb);
                o[dt] = MFMA32(a, pf[kt][sx], o[dt]);
            }
    }
#pragma unroll
    for (int dt = 0; dt < 4; ++dt)
#pragma unroll
        for (int i4 = 0; i4 < 4; ++i4) {
            u32x2 wv; wv.x = pk2(o[dt][4 * i4] * rl, o[dt][4 * i4 + 1] * rl); wv.y = pk2(o[dt][4 * i4 + 2] * rl, o[dt][4 * i4 + 3] * rl);
            if (!dry) *(u32x2*)(qrow + 32 * dt + 8 * i4 + 4 * h) = wv;
        }
    if (h == 0 && !dry) lsep[(size_t)(32 * w + ql) * 16] = m * LN2 + __logf(l);
}

#define XB_TMO      128
#define XB_XCNT(j)  (256  + 64 * (j))
#define XB_XSUB(j)  (1280 + 64 * (j))
#define XB_XGEN(j)  (2304 + 64 * (j))
#define XB_TOP      3328
#define XB_TOPGEN   3392
#define XCD_BAR_WORDS 3456
#define XB_SPIN_CAP (1u << 18)

__device__ __forceinline__ unsigned xb_ld(unsigned* p)              { return __hip_atomic_load(p, __ATOMIC_RELAXED, __HIP_MEMORY_SCOPE_AGENT); }
__device__ __forceinline__ unsigned xb_add(unsigned* p, unsigned v) { return __hip_atomic_fetch_add(p, v, __ATOMIC_RELAXED, __HIP_MEMORY_SCOPE_AGENT); }
__device__ __forceinline__ unsigned xb_xcc_id() { return (unsigned)__builtin_amdgcn_s_getreg((3 << 11) | 20) & 0xFu; }
#define XB_SPIN(cond, bar) do { unsigned _sp = 0; while (cond) { __builtin_amdgcn_s_sleep(1); \
    if ((++_sp & 255u) == 0u) { if (xb_ld(&(bar)[XB_TMO])) break; if (_sp > XB_SPIN_CAP) { atomicAdd(&(bar)[XB_TMO], 1u); break; } } } } while (0)

struct XcdBarrier {
    unsigned* bar; unsigned x;
    volatile LAS unsigned* st;
};

__device__ __forceinline__ XcdBarrier xcd_barrier_post(unsigned* bar, volatile LAS unsigned* st) {
    XcdBarrier b; b.bar = bar; b.x = xb_xcc_id(); b.st = st;
    if (threadIdx.x == 0) (void)xb_add(&bar[XB_XCNT(b.x)], 1u);
    return b;
}
__device__ __forceinline__ void xcd_barrier_complete(unsigned* bar, unsigned x, unsigned& nloc, unsigned& nx) {
    const unsigned G = gridDim.x * gridDim.y * gridDim.z;
    unsigned sum, cnt, mine, sp = 0u;
    for (;;) {
        sum = 0u; cnt = 0u; mine = 0u;
#pragma unroll
        for (unsigned j = 0; j < 16; ++j) { const unsigned c = xb_ld(&bar[XB_XCNT(j)]); sum += c; cnt += (c > 0u) ? 1u : 0u; mine = (j == x) ? c : mine; }
        if (sum == G) break;
        __builtin_amdgcn_s_sleep(1);
        if ((++sp & 255u) == 0u) { if (xb_ld(&bar[XB_TMO])) break; if (sp > XB_SPIN_CAP) { atomicAdd(&bar[XB_TMO], 1u); break; } }
    }
    nloc = mine > 0u ? mine : 1u; nx = cnt > 0u ? cnt : 1u;
}

__device__ __forceinline__ void xcd_barrier(const XcdBarrier& b) {
    asm volatile("s_waitcnt vmcnt(0)" ::: "memory");
    __syncthreads();
    if (threadIdx.x == 0) {
        unsigned* bar = b.bar;
        __builtin_amdgcn_s_waitcnt(0);
        unsigned nloc = b.st[0], nx = b.st[1];
        if (nloc == 0u) { xcd_barrier_complete(bar, b.x, nloc, nx); b.st[0] = nloc; b.st[1] = nx; }
        const unsigned old = xb_add(&bar[XB_XSUB(b.x)], 1u);
        const unsigned gen = old / nloc;
        if (old + 1u == (gen + 1u) * nloc) {
            __builtin_amdgcn_fence(__ATOMIC_RELEASE, "agent");
            asm volatile("s_waitcnt vmcnt(0)" ::: "memory");
            const unsigned og = xb_add(&bar[XB_TOP], 1u);
            const unsigned tg = og / nx;
            if (og + 1u == (tg + 1u) * nx) xb_add(&bar[XB_TOPGEN], 1u);
            else XB_SPIN(xb_ld(&bar[XB_TOPGEN]) == tg, bar);
            __builtin_amdgcn_fence(__ATOMIC_ACQUIRE, "agent");
            xb_add(&bar[XB_XGEN(b.x)], 1u);
            asm volatile("s_waitcnt vmcnt(0)" ::: "memory");
        } else {
            XB_SPIN(xb_ld(&bar[XB_XGEN(b.x)]) == gen, bar);
            __builtin_amdgcn_fence(__ATOMIC_ACQUIRE, "agent");
            asm volatile("s_waitcnt vmcnt(0)" ::: "memory");
        }
    }
    __syncthreads();
}


struct Params {
    const float *x, *mem, *norm_a, *w_in_a, *w_out_a, *norm_b, *w_in_b, *w_out_b, *w_mem_kv, *mem_norm_g, *kv_norm_g, *w_kv, *final_norm_g;
    float* out; unsigned char* ws; int ph_lo, ph_hi;
};
enum { K_PRO = 0, K_A_GEMM, K_A_STATE, K_A_RETOUT, K_A_OUT, K_A_NORM, K_KV, K_B_NORM, K_B_GEMM, K_B_ATTN, K_B_MERGE, K_B_OUT, K_FINAL };

struct TrJob { const float* W; int K, N, nsrc0, ncols; bf16_t* WT; int drow0; };
DI bool tr_job(const Params& p, int kind, int la, int lb, int j, TrJob& t) {
    unsigned char* ws = p.ws;
    bf16_t* Win = (bf16_t*)(ws + WS_WIN); bf16_t* Wout = (bf16_t*)(ws + WS_WOUT);
    if (kind == K_PRO || (kind == K_A_NORM && la == 0)) {
        const int l = (kind == K_PRO) ? 0 : 1;
        if (j == 0) { t = TrJob{p.w_in_a + (size_t)l * 2048 * 8192, 2048, 8192, 0, 8192, Win, 0}; return true; }
        if (j == 1) { t = TrJob{p.w_out_a + (size_t)l * 3072 * 2048, 3072, 2048, 0, 2048, Wout, 0}; return true; }
        if (kind == K_PRO && j < 6) { t = TrJob{p.w_mem_kv + (size_t)(j - 2) * 2048 * 2048, 2048, 2048, 0, 2048, (bf16_t*)(ws + WS_WMEMT), (j - 2) * 2048}; return true; }
        return false;
    }
    if (kind == K_A_NORM) { if (j == 0) { t = TrJob{p.w_kv, 2048, 12288, 0, 12288, (bf16_t*)(ws + WS_WKVT), 0}; return true; } return false; }
    if (kind == K_B_NORM) {
        const float* wi = p.w_in_b + (size_t)lb * 2048 * 10240;
        switch (j) {
            case 0: t = TrJob{wi, 2048, 10240, 0, 2048, Win, 0}; return true;
            case 1: t = TrJob{wi, 2048, 10240, 8192, 1024, Win, 2048}; return true;
            case 2: t = TrJob{wi, 2048, 10240, 9216, 1024, Win, 3072}; return true;
            case 3: t = TrJob{wi, 2048, 10240, 6144, 2048, Win, 4096}; return true;
            case 4: t = TrJob{wi, 2048, 10240, 2048, 2048, Win, 6144}; return true;
            case 5: t = TrJob{wi, 2048, 10240, 4096, 2048, Win, 8192}; return true;
            case 6: t = TrJob{p.w_out_b + (size_t)lb * 3072 * 2048, 3072, 2048, 0, 2048, Wout, 0}; return true;
            default: return false;
        }
    }
    return false;
}
DI bool gemm_job(const Params& p, int kind, int la, int j, int G, int bid, pg8::Gemm& g, pg8::EpiBf16& E, int& c) {
    unsigned char* ws = p.ws; c = bid;
    bf16_t* Win = (bf16_t*)(ws + WS_WIN);
    if (kind == K_A_GEMM) {
        if (j == 0) { g = pg8::Gemm{(bf16_t*)(ws + WS_HA), Win, T_TOK, 8192, 2048, 2048, 1}; E = pg8::EpiBf16{(bf16_t*)(ws + WS_PROJA), 8192, 0, nullptr, 1}; return true; }
        if (j == 1 && la == 0) { g = pg8::Gemm{(bf16_t*)(ws + WS_MEMN), (bf16_t*)(ws + WS_WMEMT), 1024, 8192, 2048, 2048, 1}; E = pg8::EpiBf16{(bf16_t*)(ws + WS_MEMKV), 8192, 0, nullptr, 1}; c = (bid + G / 2) % G; return true; }
        return false;
    }
    if (kind == K_KV) {
        if (j >= 3) return false;
        const int dil = (j == 0) ? 1 : (j == 1 ? 4 : 16);
        g = pg8::Gemm{(bf16_t*)(ws + WS_HA), (bf16_t*)(ws + WS_WKVT) + (size_t)j * 4096 * 2048, T_TOK, 4096, 2048, 2048, dil};
        E = pg8::EpiBf16{(bf16_t*)(ws + WS_KV) + (size_t)j * T_TOK * 4096, 4096, 1, nullptr, dil}; return true;
    }
    if (kind == K_B_GEMM) {
        bf16_t* hB = (bf16_t*)(ws + WS_HB); bf16_t* projB = (bf16_t*)(ws + WS_P);
        if (j == 0) { g = pg8::Gemm{hB, Win, 8192, 6144, 2048, 2048, 1}; E = pg8::EpiBf16{projB, 10240, 0, nullptr, 1}; return true; }
        if (j == 1) { g = pg8::Gemm{hB, Win + (size_t)6144 * 2048, 8192, 2048, 2048, 2048, 4}; E = pg8::EpiBf16{projB + 6144, 10240, 0, nullptr, 4}; return true; }
        if (j == 2) { g = pg8::Gemm{hB, Win + (size_t)8192 * 2048, 8192, 2048, 2048, 2048, 16}; E = pg8::EpiBf16{projB + 8192, 10240, 0, nullptr, 16}; return true; }
        return false;
    }
    return false;
}

__global__ void __launch_bounds__(NT, 2) yoco_fwd(Params p) {
    extern __shared__ __attribute__((aligned(16))) unsigned char lds_raw[];
    LAS unsigned char* lds = (LAS unsigned char*)lds_raw;
    const int G = gridDim.x, bid = blockIdx.x;
    volatile LAS unsigned* bst = (volatile LAS unsigned*)(lds + LDS_BYTES - 16);
    if (threadIdx.x < 2) bst[threadIdx.x] = 0u;
    __syncthreads();
    XcdBarrier xbar = xcd_barrier_post((unsigned*)(p.ws + WS_BAR), bst);
#pragma unroll 1
    for (int ph = p.ph_lo; ph < p.ph_hi; ++ph) {
        int tid = threadIdx.x;
        asm volatile("" : "+v"(tid)); __builtin_assume(tid >= 0 && tid < NT);
        const int lane = tid & 63, wave = __builtin_amdgcn_readfirstlane(tid >> 6);
        const int gw = bid * 8 + wave, ngw = G * 8;
        unsigned char* ws = p.ws;
        int kind, la = 0, lb = 0, hb = 0;
        if (ph == 0) kind = K_PRO;
        else if (ph <= 10) { la = (ph - 1) / 5; kind = K_A_GEMM + (ph - 1) % 5; }
        else if (ph == 11) kind = K_KV;
        else if (ph <= 31) { const int idx = ph - 12; lb = idx / 10; hb = (idx / 5) % 2; kind = K_B_NORM + idx % 5; }
        else kind = K_FINAL;

        if (kind == K_PRO || kind == K_A_NORM || (kind == K_B_NORM && hb == 0)) {
            LAS float* scr = (LAS float*)(lds + wave * 16640);
            TrJob t;
#pragma unroll 1
            for (int j = 0; tr_job(p, kind, la, lb, j, t); ++j) transpose_seg(t.W, t.K, t.N, t.nsrc0, t.ncols, t.WT, t.drow0, scr, gw, ngw, lane);
        }
        if (kind == K_PRO || kind == K_A_NORM || kind == K_B_NORM) {
            if (kind == K_PRO) {
                norm_rows(p.mem, p.mem_norm_g, (bf16_t*)(ws + WS_MEMN), 1024, gw, ngw, lane);
                float* cosT = (float*)(ws + WS_COS); float* sinT = (float*)(ws + WS_SIN);
                for (int i = bid * NT + tid; i < 4096 * 64; i += G * NT) { const int pos = i >> 6, j = i & 63;
                    const float inv = 1.0f / powf(10000.0f, (float)j * (1.0f / 63.0f)); const float ang = (float)pos * inv;
                    cosT[i] = cosf(ang); sinT[i] = sinf(ang); }
            }
            const float* xin; const float* gg; bf16_t* ho; int nrows;
            if (kind == K_PRO) { xin = p.x; gg = p.norm_a; ho = (bf16_t*)(ws + WS_HA); nrows = T_TOK; }
            else if (kind == K_A_NORM) { xin = p.out; gg = (la == 0) ? p.norm_a + 2048 : p.kv_norm_g; ho = (bf16_t*)(ws + WS_HA); nrows = T_TOK; }
            else { xin = p.out + (size_t)hb * 8192 * DM; gg = p.norm_b + lb * 2048; ho = (bf16_t*)(ws + WS_HB); nrows = 8192; }
            norm_rows(xin, gg, ho, nrows, gw, ngw, lane);
        }
        if (kind == K_A_GEMM || kind == K_KV || kind == K_B_GEMM) {
            pg8::Gemm g; pg8::EpiBf16 E; int c;
#pragma unroll 1
            for (int rep = 0; rep < 1 + PROBE_GEMM; ++rep)
#pragma unroll 1
            for (int j = 0; gemm_job(p, kind, la, j, G, bid, g, E, c); ++j) { pg8::StaticOrder S; S.init(g.M, g.N, G, c); pg8::gemm_phase(lds, g, S, E); }
        }
        if (kind == K_A_OUT || kind == K_B_OUT) {
            pg8::Gemm g; pg8::EpiRes E;
            if (kind == K_A_OUT) { g = pg8::Gemm{(bf16_t*)(ws + WS_MIXA), (bf16_t*)(ws + WS_WOUT), T_TOK, 2048, 3072, 3072, 1}; E = pg8::EpiRes{la == 0 ? p.x : p.out, p.out}; }
            else { float* xh = p.out + (size_t)hb * 8192 * DM; g = pg8::Gemm{(bf16_t*)(ws + WS_P), (bf16_t*)(ws + WS_WOUT), 8192, 2048, 3072, 10240, 1}; E = pg8::EpiRes{xh, xh}; }
            pg8::StaticOrder S; S.init(g.M, g.N, G, bid); pg8::gemm_phase(lds, g, S, E);
        }
        if (kind == K_A_STATE) {
#pragma unroll 1
            for (int rep = 0; rep < 1 + PROBE_RET; ++rep)
#pragma unroll 1
            for (int it = bid; it < 128; it += G) { __syncthreads(); ret_state_item(lds, (bf16_t*)(ws + WS_PROJA), (bf16_t*)(ws + WS_RPREV), (float*)(ws + WS_COS), (float*)(ws + WS_SIN), it, tid); }
        }
        if (kind == K_B_ATTN) {
            bf16_t* projB = (bf16_t*)(ws + WS_P); float* lse = (float*)(ws + WS_LSE);
#pragma unroll 1
            for (int rep = 0; rep < 1 + PROBE_ATTN; ++rep)
#pragma unroll 1
            for (int it = bid; it < 1536; it += G) {
                const bool dry = PROBE_ATTN && (rep + p.ph_lo == 0);
                const int head = it & 15, blkr = (it >> 4) & 31, gi = it >> 9;
                const int n = (gi == 0) ? 4096 : (gi == 1 ? 1024 : 256);
                const int colq = (gi == 0) ? 0 : (gi == 1 ? 6144 : 8192);
                const int ml0 = blkr * 256, i0 = (ml0 & 4095) % n; const size_t mg0 = (size_t)hb * 8192 + ml0;
                const bf16_t* kvg = (bf16_t*)(ws + WS_KV) + (size_t)gi * T_TOK * 4096;
                dil_attn_item(lds, projB + (size_t)ml0 * 10240 + colq + head * 128, 10240, kvg + ((size_t)head * T_TOK + mg0) * 128, kvg + ((size_t)(16 + head) * T_TOK + mg0) * 128,
                              lse + ((size_t)gi * 8192 + ml0) * 16 + head, i0, tid, dry);
            }
        }
        if (kind == K_A_STATE || kind == K_B_ATTN) {
            const bool isA = (kind == K_A_STATE);
            const int nit = isA ? 256 : 128;
            const int first = (isA && G >= 256) ? 128 : 0;
            const bf16_t* memKV = (bf16_t*)(ws + WS_MEMKV);
            if (bid >= first) {
#pragma unroll 1
                for (int rep = 0; rep < 1 + (PROBE_ATTN | PROBE_RET); ++rep)
#pragma unroll 1
                for (int it = bid - first; it < nit; it += G - first) {
                    const bool dry = (PROBE_ATTN | PROBE_RET) && (rep + p.ph_lo == 0);
                    const int mh = it & 3, blkr = it >> 2; const size_t row0 = (size_t)blkr * 256;
                    const int b = isA ? (blkr >> 4) : (hb * 2 + (blkr >> 4)); const int layer = isA ? la : 2 + lb;
                    const bf16_t* km = memKV + (size_t)b * 256 * 8192 + layer * 2048 + mh * 256;
                    const bf16_t* qp; const bf16_t* gp; bf16_t* op; size_t ldq, ldo;
                    if (isA) { const bf16_t* pa = (bf16_t*)(ws + WS_PROJA) + row0 * 8192; qp = pa + 6144 + mh * 256; gp = pa + 7168 + mh * 256; ldq = 8192; op = (bf16_t*)(ws + WS_MIXA) + row0 * 3072 + 2048 + mh * 256; ldo = 3072; }
                    else { bf16_t* pb = (bf16_t*)(ws + WS_P) + row0 * 10240; qp = pb + 2048 + mh * 256; gp = pb + 3072 + mh * 256; ldq = 10240; op = pb + 2048 + mh * 256; ldo = 10240; }
                    mem_attn_item(lds, qp, ldq, gp, ldq, op, ldo, km, km + 1024, tid, dry);
                }
            }
        }
        if (kind == K_A_RETOUT) {
#pragma unroll 1
            for (int rep = 0; rep < 1 + PROBE_RET; ++rep)
#pragma unroll 1
            for (int it = bid; it < 1024; it += G) ret_out_item(lds, (bf16_t*)(ws + WS_PROJA), (bf16_t*)(ws + WS_RPREV), (bf16_t*)(ws + WS_MIXA), (float*)(ws + WS_COS), (float*)(ws + WS_SIN), it, tid);
        }
        if (kind == K_B_MERGE) {
            bf16_t* projB = (bf16_t*)(ws + WS_P); const float* lse = (const float*)(ws + WS_LSE);
#pragma unroll 1
            for (int rep = 0; rep < 1 + PROBE_ATTN; ++rep)
#pragma unroll 1
            for (int tl = gw; tl < 8192; tl += ngw) {
                const bool dry = PROBE_ATTN && (rep + p.ph_lo == 0);
                const int b = tl >> 12, ti = tl & 4095;
                const int m1 = b * 4096 + (ti & 3) * 1024 + (ti >> 2), m2 = b * 4096 + (ti & 15) * 256 + (ti >> 4);
                bf16_t* r0 = projB + (size_t)tl * 10240; const bf16_t* r1 = projB + (size_t)m1 * 10240 + 6144; const bf16_t* r2 = projB + (size_t)m2 * 10240 + 8192;
#pragma unroll
                for (int j = 0; j < 4; ++j) {
                    const int col = j * 512 + lane * 8, head = col >> 7;
                    const float l0 = lse[(size_t)tl * 16 + head], l1 = lse[((size_t)8192 + m1) * 16 + head], l2 = lse[((size_t)16384 + m2) * 16 + head];
                    const float mx = fmaxf(l0, fmaxf(l1, l2));
                    float a0 = __expf(l0 - mx), a1 = __expf(l1 - mx), a2 = __expf(l2 - mx); const float rs = 1.f / (a0 + a1 + a2); a0 *= rs; a1 *= rs; a2 *= rs;
                    const u32x4 v0 = *(const u32x4*)(r0 + col), v1 = *(const u32x4*)(r1 + col), v2 = *(const u32x4*)(r2 + col), gv = *(const u32x4*)(r0 + 4096 + col);
                    u32x4 ov;
#pragma unroll
                    for (int k = 0; k < 4; ++k) {
                        const float ea = a0 * bflo(v0[k]) + a1 * bflo(v1[k]) + a2 * bflo(v2[k]), eb = a0 * bfhi(v0[k]) + a1 * bfhi(v1[k]) + a2 * bfhi(v2[k]);
                        ov[k] = pk2(ea * silu_f(bflo(gv[k])), eb * silu_f(bfhi(gv[k])));
                    }
                    if (!dry) *(u32x4*)(r0 + col) = ov;
                }
            }
        }
        if (kind == K_FINAL) {
#pragma unroll 1
            for (int m = gw; m < T_TOK; m += ngw) {
                float* xr = p.out + (size_t)m * DM;
                f32x4 v[8]; float s = 0.f;
#pragma unroll
                for (int j = 0; j < 8; ++j) { v[j] = ((const f32x4*)xr)[lane + 64 * j]; s += (v[j].x * v[j].x + v[j].y * v[j].y) + (v[j].z * v[j].z + v[j].w * v[j].w); }
                const float rstd = rsqrtf(wave_sum(s) * (1.f / DM) + EPS);
#pragma unroll
                for (int j = 0; j < 8; ++j) { const f32x4 gg = ((const f32x4*)p.final_norm_g)[lane + 64 * j]; ((f32x4*)xr)[lane + 64 * j] = v[j] * rstd * gg; }
            }
        }
        if (ph + 1 < p.ph_hi) { if (ph == p.ph_lo) cg::this_grid().sync(); else xcd_barrier(xbar); }
    }
}

constexpr int N_PHASES = 1 + 2 * 5 + 1 + 4 * 5 + 1;

extern "C" void kernel_launch(void* const* d_in, const int* in_sizes, int n_in, void* d_out, int out_size, void* d_ws, size_t ws_size, hipStream_t stream) {
    static int grid = 0;
    if (grid == 0) {
        if (ws_size < WS_END) { fprintf(stderr, "kernel_launch: workspace too small: %zu < %zu\n", ws_size, (size_t)WS_END); grid = -1; return; }
        int dev = 0, cus = 0, per_cu = 0;
        hipGetDevice(&dev);
        hipDeviceGetAttribute(&cus, hipDeviceAttributeMultiprocessorCount, dev);
        if (hipFuncSetAttribute((const void*)yoco_fwd, hipFuncAttributeMaxDynamicSharedMemorySize, LDS_BYTES) != hipSuccess) { fprintf(stderr, "kernel_launch: hipFuncSetAttribute failed\n"); grid = -1; return; }
        if (hipOccupancyMaxActiveBlocksPerMultiprocessor(&per_cu, (const void*)yoco_fwd, NT, LDS_BYTES) != hipSuccess || per_cu < 1) { fprintf(stderr, "kernel_launch: occupancy query gave %d\n", per_cu); per_cu = 1; }
        (void)hipGetLastError();
        grid = cus;
        fprintf(stderr, "kernel_launch: grid %d (cus %d, per_cu %d), ws %zu\n", grid, cus, per_cu, ws_size);
    }
    if (grid < 0) return;
    (void)hipMemsetAsync((char*)d_ws + WS_BAR, 0, 16384, stream);
    Params p{};
    p.x = (const float*)d_in[0]; p.mem = (const float*)d_in[1]; p.norm_a = (const float*)d_in[2]; p.w_in_a = (const float*)d_in[3]; p.w_out_a = (const float*)d_in[4];
    p.norm_b = (const float*)d_in[5]; p.w_in_b = (const float*)d_in[6]; p.w_out_b = (const float*)d_in[7]; p.w_mem_kv = (const float*)d_in[8]; p.mem_norm_g = (const float*)d_in[9];
    p.kv_norm_g = (const float*)d_in[10]; p.w_kv = (const float*)d_in[11]; p.final_norm_g = (const float*)d_in[12];
    p.out = (float*)d_out; p.ws = (unsigned char*)d_ws;
#if MK_SPLIT
    for (int k = 0; k < N_PHASES; ++k) {
        p.ph_lo = k; p.ph_hi = k + 1;
        hipLaunchKernelGGL(yoco_fwd, dim3(grid), dim3(NT), LDS_BYTES, stream, p);
    }
#else
    p.ph_lo = 0; p.ph_hi = N_PHASES;
    void* args[] = {&p};
    hipError_t e = hipLaunchCooperativeKernel((const void*)yoco_fwd, dim3(grid), dim3(NT), args, LDS_BYTES, stream);
    if (e != hipSuccess) fprintf(stderr, "cooperative launch failed: %s (grid %d)\n", hipGetErrorString(e), grid);
#endif
}
```

```cpp
#include <hip/hip_runtime.h>
#include <hip/hip_cooperative_groups.h>
#include <cstdio>
#include <cstdint>
namespace cg = cooperative_groups;

#ifndef MK_SPLIT
#define MK_SPLIT 0
#endif

#ifndef PROBE_GEMM
#define PROBE_GEMM 0
#endif
#ifndef PROBE_RET
#define PROBE_RET 0
#endif
#ifndef PROBE_ATTN
#define PROBE_ATTN 0
#endif
#define LAS __attribute__((address_space(3)))
#define DI __device__ __forceinline__
typedef unsigned short bf16_t;
typedef short bf16x8 __attribute__((ext_vector_type(8)));
typedef short s16x4 __attribute__((ext_vector_type(4)));
typedef float f32x4 __attribute__((ext_vector_type(4)));
typedef float f32x16 __attribute__((ext_vector_type(16)));
typedef unsigned u32x4 __attribute__((ext_vector_type(4)));
typedef unsigned u32x2 __attribute__((ext_vector_type(2)));
typedef __bf16 nbf16x2 __attribute__((ext_vector_type(2)));

constexpr int NT = 512;
constexpr int T_TOK = 16384, DM = 2048, SEQ = 4096;
constexpr int LDS_BYTES = 144 * 1024;
constexpr float EPS = 1e-6f;
constexpr float LOG2E = 1.4426950408889634f, LN2 = 0.6931471805599453f;

constexpr size_t MiB = 1048576;
constexpr size_t WS_KV   = 0;
constexpr size_t WS_PROJA = 0;
constexpr size_t WS_MIXA = 256 * MiB;
constexpr size_t WS_WMEMT = 352 * MiB;
constexpr size_t WS_P    = 384 * MiB;
constexpr size_t WS_HA   = 384 * MiB;
constexpr size_t WS_RPREV = 448 * MiB;
constexpr size_t WS_WKVT = 448 * MiB;
constexpr size_t WS_MEMN = 512 * MiB;
constexpr size_t WS_HB   = 544 * MiB;
constexpr size_t WS_WIN  = 608 * MiB;
constexpr size_t WS_WOUT = 648 * MiB;
constexpr size_t WS_MEMKV = 660 * MiB;
constexpr size_t WS_COS  = 676 * MiB;
constexpr size_t WS_SIN  = 677 * MiB;
constexpr size_t WS_LSE  = 678 * MiB;
constexpr size_t WS_BAR  = 679 * MiB + 512 * 1024;
constexpr size_t WS_SS   = 679 * MiB + 512 * 1024 + 65536;
constexpr size_t WS_END  = 680 * MiB;

DI unsigned pk2(float a, float b) { nbf16x2 v; v[0] = (__bf16)a; v[1] = (__bf16)b; return __builtin_bit_cast(unsigned, v); }
DI float bflo(unsigned u) { return __uint_as_float(u << 16); }
DI float bfhi(unsigned u) { return __uint_as_float(u & 0xffff0000u); }
DI float silu_f(float x) { return x / (1.f + __expf(-x)); }
DI int crow(int i, int h) { return (i & 3) + 8 * (i >> 2) + 4 * h; }
DI float wave_sum(float v) {
#pragma unroll
    for (int o = 32; o >= 1; o >>= 1) v += __shfl_xor(v, o);
    return v;
}
#define MFMA32(a, b, c) __builtin_amdgcn_mfma_f32_32x32x16_bf16((a), (b), (c), 0, 0, 0)
template <int S> DI bf16x8 pack8(const f32x16& x) {
    u32x4 p; p[0] = pk2(x[8 * S], x[8 * S + 1]); p[1] = pk2(x[8 * S + 2], x[8 * S + 3]); p[2] = pk2(x[8 * S + 4], x[8 * S + 5]); p[3] = pk2(x[8 * S + 6], x[8 * S + 7]);
    return __builtin_bit_cast(bf16x8, p);
}
DI bf16x8 tr_pair(LAS unsigned char* lo_p, LAS unsigned char* hi_p) {
    s16x4 lo = __builtin_amdgcn_ds_read_tr16_b64_v4i16((LAS s16x4*)lo_p);
    s16x4 hi = __builtin_amdgcn_ds_read_tr16_b64_v4i16((LAS s16x4*)hi_p);
    return __builtin_shufflevector(lo, hi, 0, 1, 2, 3, 4, 5, 6, 7);
}
DI f32x16 zero16() { f32x16 z; for (int i = 0; i < 16; ++i) z[i] = 0.f; return z; }

namespace pg8 {
constexpr int BM = 256, BK = 64, HALF = 128, HTB = HALF * BK * 2, STAGE_BYTES = 8 * HTB, NXCD = 8, WGM = 8;
DI int lds_byte(int r, int c) { const int st = (r >> 4) * 2 + (c >> 5), rr = r & 15, cc = c & 31, ob = rr * 64 + cc * 2; return st * 1024 + (ob ^ (((ob >> 9) & 1) << 5)); }
DI void stage_rc(int b, int& R, int& C) { const int st = b / 1024, sb = b % 1024, swz = sb ^ (((sb >> 9) & 1) << 5); R = (st >> 1) * 16 + swz / 64; C = (st & 1) * 32 + (swz % 64) / 2; }
DI int perm32(int rho) { const int n = rho >> 4, i = rho & 15; return 8 * (i >> 2) + 4 * n + (i & 3); }
struct Unit { int pm, pn; };
struct Gemm { const bf16_t* A; const bf16_t* Bt; int M, N, K, lda, dil; };
DI size_t arow0(int pm, int dil) {
    const int m0 = pm * BM; if (dil == 1) return (size_t)m0;
    const int b = m0 >> 12, rem = m0 & 4095, n = 4096 / dil, r = rem / n, i0 = rem % n;
    return (size_t)(b * 4096 + i0 * dil + r);
}
struct StaticOrder {
    int nM, nN, nwg, G, c;
    DI void init(int M, int N, int G_, int c_) { nM = M / BM; nN = N / BM; nwg = nM * nN; G = G_; c = c_; }
    DI bool next(int i, Unit& u) const {
        const long L = (long)i * G + c; if (L >= nwg) return false;
        int wgid = (int)L; { const int q = nwg / NXCD, r = nwg % NXCD, xcd = wgid % NXCD, off = wgid / NXCD; wgid = (xcd < r ? xcd * (q + 1) : r * (q + 1) + (xcd - r) * q) + off; }
        const int nig = WGM * nN, gid = wgid / nig, fm = gid * WGM, gsz = (nM - fm) < WGM ? (nM - fm) : WGM;
        u.pm = fm + ((wgid % nig) % gsz); u.pn = (wgid % nig) / gsz; return true;
    }
};
struct EpiBf16 {
    static constexpr bool PERM = true;
    bf16_t* O; int ldc; int hm; const float* ss; int dil;
    DI void operator()(const f32x4 (&acc)[2][2][4][2], const Unit& u, int wr, int wc, int fr, int fq) const {
        const int row0 = u.pm * BM + wr * 64 + fr, col0 = u.pn * BM + wc * 32 + 8 * fq;
        const size_t tok0 = arow0(u.pm, dil);
#pragma unroll
        for (int ai = 0; ai < 2; ++ai)
#pragma unroll
            for (int m = 0; m < 4; ++m) { const int row = row0 + ai * HALF + m * 16;
                float rs = 1.f;
                if (ss) rs = rsqrtf(ss[tok0 + (size_t)(wr * 64 + fr + ai * HALF + m * 16) * dil] * (1.f / DM) + EPS);
#pragma unroll
                for (int bj = 0; bj < 2; ++bj) { const f32x4 v0 = acc[ai][bj][m][0] * rs, v1 = acc[ai][bj][m][1] * rs;
                    u32x4 w; w.x = pk2(v0[0], v0[1]); w.y = pk2(v0[2], v0[3]); w.z = pk2(v1[0], v1[1]); w.w = pk2(v1[2], v1[3]);
                    const int col = col0 + bj * HALF;
                    bf16_t* dst = hm ? O + ((size_t)(col >> 7) * T_TOK + row) * 128 + (col & 127) : O + (size_t)row * ldc + col;
                    *(u32x4*)dst = w; } }
    }
};
struct EpiRes {
    static constexpr bool PERM = true;
    const float* xin; float* xout; const float* g1; bf16_t* h1; const float* g2; bf16_t* h2; float* ss;
    DI void operator()(const f32x4 (&acc)[2][2][4][2], const Unit& u, int wr, int wc, int fr, int fq) const {
        const int row0 = u.pm * BM + wr * 64 + fr, col0 = u.pn * BM + wc * 32 + 8 * fq;
        f32x4 ga[2][2], gb[2][2];
#pragma unroll
        for (int bj = 0; bj < 2; ++bj)
#pragma unroll
            for (int n = 0; n < 2; ++n) { ga[bj][n] = h1 ? *(const f32x4*)(g1 + col0 + bj * HALF + n * 4) : (f32x4){0.f, 0.f, 0.f, 0.f}; gb[bj][n] = h2 ? *(const f32x4*)(g2 + col0 + bj * HALF + n * 4) : (f32x4){0.f, 0.f, 0.f, 0.f}; }
#pragma unroll
        for (int ai = 0; ai < 2; ++ai)
#pragma unroll
            for (int m = 0; m < 4; ++m) { const int row = row0 + ai * HALF + m * 16; const size_t off = (size_t)row * DM + col0;
                f32x4 b[2][2];
#pragma unroll
                for (int bj = 0; bj < 2; ++bj)
#pragma unroll
                    for (int n = 0; n < 2; ++n) b[bj][n] = *(const f32x4*)(xin + off + bj * HALF + n * 4);
                float sq = 0.f;
#pragma unroll
                for (int bj = 0; bj < 2; ++bj) {
#pragma unroll
                    for (int n = 0; n < 2; ++n) { b[bj][n] = b[bj][n] + acc[ai][bj][m][n]; *(f32x4*)(xout + off + bj * HALF + n * 4) = b[bj][n];
                        sq += (b[bj][n].x * b[bj][n].x + b[bj][n].y * b[bj][n].y) + (b[bj][n].z * b[bj][n].z + b[bj][n].w * b[bj][n].w); }
                    if (h1) { const f32x4 p0 = b[bj][0] * ga[bj][0], p1 = b[bj][1] * ga[bj][1];
                        u32x4 w; w.x = pk2(p0.x, p0.y); w.y = pk2(p0.z, p0.w); w.z = pk2(p1.x, p1.y); w.w = pk2(p1.z, p1.w); *(u32x4*)(h1 + off + bj * HALF) = w; }
                    if (h2) { const f32x4 p0 = b[bj][0] * gb[bj][0], p1 = b[bj][1] * gb[bj][1];
                        u32x4 w; w.x = pk2(p0.x, p0.y); w.y = pk2(p0.z, p0.w); w.z = pk2(p1.x, p1.y); w.w = pk2(p1.z, p1.w); *(u32x4*)(h2 + off + bj * HALF) = w; }
                }
                if (ss) { sq += __shfl_xor(sq, 16); sq += __shfl_xor(sq, 32); if (fq == 0) atomicAdd(ss + row, sq); }
            }
    }
};

template <class Epi>
DI void gemm_phase(LAS unsigned char* lds, const Gemm g, const StaticOrder& S, const Epi& E) {
    int tid = threadIdx.x;
    asm volatile("" : "+v"(tid)); __builtin_assume(tid >= 0 && tid < NT);
    const int wid = __builtin_amdgcn_readfirstlane(tid >> 6), lane = tid & 63, wr = wid >> 2, wc = wid & 3, fr = lane & 15, fq = lane >> 4;
    const int K = g.K, nt = K / BK;
    unsigned voffA[2], voffB[2];
#pragma unroll
    for (int i = 0; i < 2; ++i) { int R, C; stage_rc(tid * 16 + i * 8192, R, C); const int Rb = Epi::PERM ? ((R & ~31) + perm32(R & 31)) : R;
        voffA[i] = (unsigned)(R * g.dil * g.lda + C) * 2u; voffB[i] = (unsigned)(Rb * K + C) * 2u; }
    const size_t kstep = (size_t)(BK * 2);
    const size_t hstepA = (size_t)HALF * g.dil * g.lda * 2, hstepB = (size_t)HALF * K * 2, tstepB = 2 * hstepB;
    const unsigned ldsw = (unsigned)wid * 1024u;
    const int aoff = lds_byte(wr * 64 + fr, fq * 8), boff = lds_byte(wc * 32 + fr, fq * 8);
#define PG8_SA(b, h) (((b) * 2 + (h)) * HTB)
#define PG8_SB(b, h) ((4 + (b) * 2 + (h)) * HTB)
#define PG8_STAGE(bufoff, gbase, voff) do { _Pragma("unroll") for (int _i = 0; _i < 2; ++_i) \
        __builtin_amdgcn_global_load_lds((const unsigned*)((const char*)(gbase) + (voff)[_i]), (LAS unsigned*)(lds + (bufoff) + ldsw + _i * 8192), 16, 0, 0); } while (0)
#define PG8_LDA(dst, b, h) do { _Pragma("unroll") for (int m = 0; m < 4; ++m) _Pragma("unroll") for (int k = 0; k < 2; ++k) dst[m][k] = *(const LAS bf16x8*)(lds + PG8_SA(b, h) + aoff + m * 2048 + k * 1024); } while (0)
#define PG8_LDB(dst, b, h) do { _Pragma("unroll") for (int n = 0; n < 2; ++n) _Pragma("unroll") for (int k = 0; k < 2; ++k) dst[n][k] = *(const LAS bf16x8*)(lds + PG8_SB(b, h) + boff + n * 2048 + k * 1024); } while (0)
#define PG8_MMA(ai, bj, At, Bt) do { __builtin_amdgcn_s_setprio(1); _Pragma("unroll") for (int m = 0; m < 4; ++m) _Pragma("unroll") for (int n = 0; n < 2; ++n) _Pragma("unroll") for (int k = 0; k < 2; ++k) \
        acc[ai][bj][m][n] = __builtin_amdgcn_mfma_f32_16x16x32_bf16(Bt[n][k], At[m][k], acc[ai][bj][m][n], 0, 0, 0); __builtin_amdgcn_s_setprio(0); } while (0)
#define PG8_WAIT_V(n) asm volatile("s_waitcnt vmcnt(" #n ")" ::: "memory")
#define PG8_WAIT_L(n) asm volatile("s_waitcnt lgkmcnt(" #n ")" ::: "memory")
#define PG8_BAR __builtin_amdgcn_s_barrier()
#define PG8_SCHED __builtin_amdgcn_sched_barrier(0)
    Unit cur, nxt; int ui = 0;
    if (!S.next(0, cur)) return;
    f32x4 acc[2][2][4][2];
#pragma unroll
    for (int a = 0; a < 2; ++a)
#pragma unroll
        for (int b = 0; b < 2; ++b)
#pragma unroll
            for (int m = 0; m < 4; ++m)
#pragma unroll
                for (int n = 0; n < 2; ++n) acc[a][b][m][n] = (f32x4){0.f, 0.f, 0.f, 0.f};
    bf16x8 At[4][2], B0[2][2], B1[2][2];
    const char* cA = (const char*)g.A + arow0(cur.pm, g.dil) * (size_t)g.lda * 2; const char* cB = (const char*)g.Bt + (size_t)cur.pn * tstepB;
    PG8_STAGE(PG8_SB(0, 0), cB, voffB); PG8_STAGE(PG8_SB(0, 1), cB + hstepB, voffB); PG8_STAGE(PG8_SA(0, 0), cA, voffA); PG8_STAGE(PG8_SA(0, 1), cA + hstepA, voffA);
    if (wr == 1) PG8_BAR;
    PG8_WAIT_V(2); PG8_BAR;
    PG8_STAGE(PG8_SB(1, 0), cB + kstep, voffB); PG8_STAGE(PG8_SA(1, 0), cA + kstep, voffA); PG8_STAGE(PG8_SB(1, 1), cB + hstepB + kstep, voffB);
    PG8_WAIT_V(6); PG8_BAR;
    for (;;) {
        const bool has_next = S.next(ui + 1, nxt);
        const char* nA = has_next ? (const char*)g.A + arow0(nxt.pm, g.dil) * (size_t)g.lda * 2 : cA; const char* nB = has_next ? (const char*)g.Bt + (size_t)nxt.pn * tstepB : cB;
        for (int t = 0; t < nt; t += 2) {
            const bool last = (t == nt - 2);
            const char* a1 = cA + (size_t)(t + 1) * kstep;
            const char* a2 = last ? nA : cA + (size_t)(t + 2) * kstep; const char* b2 = last ? nB : cB + (size_t)(t + 2) * kstep;
            const char* a3 = a2 + kstep; const char* b3 = b2 + kstep;
            PG8_LDB(B0, 0, 0); PG8_LDB(B1, 0, 1); PG8_SCHED; PG8_LDA(At, 0, 0); PG8_STAGE(PG8_SA(1, 1), a1 + hstepA, voffA);
            PG8_WAIT_V(8); PG8_WAIT_L(0); PG8_BAR; PG8_MMA(0, 0, At, B0); PG8_MMA(0, 1, At, B1); PG8_BAR; PG8_SCHED;
            PG8_LDA(At, 0, 1); PG8_STAGE(PG8_SB(0, 0), b2, voffB); PG8_STAGE(PG8_SB(0, 1), b2 + hstepB, voffB); PG8_STAGE(PG8_SA(0, 0), a2, voffA);
            PG8_WAIT_V(8); PG8_WAIT_L(0); PG8_BAR; PG8_MMA(1, 0, At, B0); PG8_MMA(1, 1, At, B1); PG8_BAR; PG8_SCHED;
            PG8_LDB(B0, 1, 0); PG8_LDB(B1, 1, 1); PG8_SCHED; PG8_LDA(At, 1, 0); PG8_STAGE(PG8_SA(0, 1), a2 + hstepA, voffA);
            PG8_WAIT_V(8); PG8_WAIT_L(0); PG8_BAR; PG8_MMA(0, 0, At, B0); PG8_MMA(0, 1, At, B1); PG8_BAR; PG8_SCHED;
            PG8_LDA(At, 1, 1); PG8_STAGE(PG8_SB(1, 0), b3, voffB); PG8_STAGE(PG8_SB(1, 1), b3 + hstepB, voffB); PG8_STAGE(PG8_SA(1, 0), a3, voffA);
            PG8_WAIT_V(8); PG8_WAIT_L(0); PG8_BAR; PG8_MMA(1, 0, At, B0); PG8_MMA(1, 1, At, B1); PG8_BAR; PG8_SCHED;
        }
        if (wr == 0) PG8_BAR;
        E(acc, cur, wr, wc, fr, fq);
        if (!has_next) break;
#pragma unroll
        for (int a = 0; a < 2; ++a)
#pragma unroll
            for (int b = 0; b < 2; ++b)
#pragma unroll
                for (int m = 0; m < 4; ++m)
#pragma unroll
                    for (int n = 0; n < 2; ++n) acc[a][b][m][n] = (f32x4){0.f, 0.f, 0.f, 0.f};
        cur = nxt; cA = nA; cB = nB; ++ui;
        if (wr == 1) PG8_BAR;
    }
    PG8_WAIT_V(0);
    PG8_BAR;
#undef PG8_SA
#undef PG8_SB
#undef PG8_STAGE
#undef PG8_LDA
#undef PG8_LDB
#undef PG8_MMA
#undef PG8_WAIT_V
#undef PG8_WAIT_L
#undef PG8_BAR
#undef PG8_SCHED
}
}

template <int NCH, int CPR>
DI void load_rows(LAS unsigned char* dst, int dstride, const bf16_t* src, size_t ld, int zrows, int tid) {
    u32x4 v[NCH];
#pragma unroll
    for (int j = 0; j < NCH; ++j) { const int c = tid + NT * j, row = c / CPR, ch = c % CPR;
        v[j] = (u32x4){0u, 0u, 0u, 0u};
        if (row >= zrows) v[j] = *(const u32x4*)(src + (ptrdiff_t)row * (ptrdiff_t)ld + ch * 8); }
#pragma unroll
    for (int j = 0; j < NCH; ++j) { const int c = tid + NT * j, row = c / CPR, ch = c % CPR;
        *(LAS u32x4*)(dst + row * dstride + ch * 16) = v[j]; }
}
template <int NCH, int CPR>
DI void ld_issue(u32x4 (&v)[NCH], const bf16_t* src, size_t ld, int zrows, int tid) {
#pragma unroll
    for (int j = 0; j < NCH; ++j) { const int c = tid + NT * j, row = c / CPR, ch = c % CPR;
        v[j] = (u32x4){0u, 0u, 0u, 0u};
        if (row >= zrows) v[j] = *(const u32x4*)(src + (ptrdiff_t)row * (ptrdiff_t)ld + ch * 8); }
}
template <int NCH, int CPR>
DI void ld_commit(LAS unsigned char* dst, int dstride, const u32x4 (&v)[NCH], int tid) {
#pragma unroll
    for (int j = 0; j < NCH; ++j) { const int c = tid + NT * j, row = c / CPR, ch = c % CPR;
        *(LAS u32x4*)(dst + row * dstride + ch * 16) = v[j]; }
}
template <bool ZETA>
DI void load_rot(LAS unsigned char* dst, int dstride, const bf16_t* src, size_t ld, const float* cosT, const float* sinT, int pos0, float scale, float log2g, int tid) {
#pragma unroll
    for (int j = 0; j < 2; ++j) {
        const int c = tid + NT * j, row = c >> 3, ch = c & 7;
        const bf16_t* p = src + (size_t)row * ld + ch * 8;
        const u32x4 a = *(const u32x4*)p, b = *(const u32x4*)(p + 64);
        const float* cp = cosT + (size_t)(pos0 + row) * 64 + ch * 8; const float* sp = sinT + (size_t)(pos0 + row) * 64 + ch * 8;
        const f32x4 c0 = *(const f32x4*)cp, c1 = *(const f32x4*)(cp + 4), s0 = *(const f32x4*)sp, s1 = *(const f32x4*)(sp + 4);
        float f = scale; if (ZETA) f *= exp2f((float)(127 - row) * log2g);
        u32x4 o1, o2;
#pragma unroll
        for (int k = 0; k < 4; ++k) {
            const float x1a = bflo(a[k]), x1b = bfhi(a[k]), x2a = bflo(b[k]), x2b = bfhi(b[k]);
            const float ca = (k < 2) ? c0[2 * k] : c1[2 * k - 4], cb = (k < 2) ? c0[2 * k + 1] : c1[2 * k - 3];
            const float sa = (k < 2) ? s0[2 * k] : s1[2 * k - 4], sb = (k < 2) ? s0[2 * k + 1] : s1[2 * k - 3];
            o1[k] = pk2((x1a * ca - x2a * sa) * f, (x1b * cb - x2b * sb) * f);
            o2[k] = pk2((x1a * sa + x2a * ca) * f, (x1b * sb + x2b * cb) * f);
        }
        *(LAS u32x4*)(dst + row * dstride + ch * 16) = o1;
        *(LAS u32x4*)(dst + row * dstride + 128 + ch * 16) = o2;
    }
}

DI void transpose_seg(const float* W, int K, int N, int nsrc0, int ncols, bf16_t* WT, int drow0, LAS float* scr, int gw, int ngw, int lane) {
    const int nblk = ncols / 64, nitems = (K / 64) * nblk;
    const int kk4 = lane >> 4, c4 = (lane & 15) * 4, c = lane & 7, n8 = lane >> 3;
    for (int item = gw; item < nitems; item += ngw) {
        const int kb = item / nblk, nb = item % nblk, k0 = 64 * kb, n0 = 64 * nb;
        const float* src = W + (size_t)(k0 + kk4) * N + nsrc0 + n0 + c4;
        f32x4 v[16];
#pragma unroll
        for (int i = 0; i < 16; ++i) v[i] = *(const f32x4*)(src + (size_t)(4 * i) * N);
#pragma unroll
        for (int i = 0; i < 16; ++i) { LAS float* d = scr + (4 * i + kk4) * 65 + c4; d[0] = v[i].x; d[1] = v[i].y; d[2] = v[i].z; d[3] = v[i].w; }
        asm volatile("s_waitcnt lgkmcnt(0)" ::: "memory");
#pragma unroll
        for (int j = 0; j < 8; ++j) { const int n = n8 + 8 * j; const LAS float* s = scr + (8 * c) * 65 + n;
            u32x4 o; o.x = pk2(s[0 * 65], s[1 * 65]); o.y = pk2(s[2 * 65], s[3 * 65]); o.z = pk2(s[4 * 65], s[5 * 65]); o.w = pk2(s[6 * 65], s[7 * 65]);
            *(u32x4*)(WT + (size_t)(drow0 + n0 + n) * K + k0 + 8 * c) = o; }
        asm volatile("s_waitcnt lgkmcnt(0)" ::: "memory");
    }
}
DI void norm_row_bf16(const float* xr, const float* g, bf16_t* o, int lane) {
    f32x4 v[8]; float s = 0.f;
#pragma unroll
    for (int j = 0; j < 8; ++j) { v[j] = ((const f32x4*)xr)[lane + 64 * j]; s += (v[j].x * v[j].x + v[j].y * v[j].y) + (v[j].z * v[j].z + v[j].w * v[j].w); }
    const float rstd = rsqrtf(wave_sum(s) * (1.f / DM) + EPS);
#pragma unroll
    for (int j = 0; j < 8; ++j) { const f32x4 gg = ((const f32x4*)g)[lane + 64 * j];
        u32x2 w; w.x = pk2(v[j].x * rstd * gg.x, v[j].y * rstd * gg.y); w.y = pk2(v[j].z * rstd * gg.z, v[j].w * rstd * gg.w);
        ((u32x2*)o)[lane + 64 * j] = w; }
}
DI void norm_rows(const float* x, const float* g, bf16_t* o, int nrows, int gw, int ngw, int lane) {
    for (int m = gw; m < nrows; m += ngw) norm_row_bf16(x + (size_t)m * DM, g, o + (size_t)m * DM, lane);
}

struct StRaw { u32x4 ka[2], kb[2], vv[2]; f32x4 c0[2], c1[2], s0[2], s1[2]; };
DI void st_issue(StRaw& r, const bf16_t* projA, const float* cosT, const float* sinT, int b, int hh, int es, int n, int tid) {
    const size_t row0 = (size_t)b * SEQ + n * 128;
#pragma unroll
    for (int j = 0; j < 2; ++j) {
        const int c = tid + NT * j, row = c >> 3, ch = c & 7;
        const bf16_t* p = projA + (row0 + row) * 8192 + 1024 + hh * 128 + ch * 8;
        r.ka[j] = *(const u32x4*)p; r.kb[j] = *(const u32x4*)(p + 64);
        const float* cp = cosT + (size_t)(n * 128 + row) * 64 + ch * 8; const float* sp = sinT + (size_t)(n * 128 + row) * 64 + ch * 8;
        r.c0[j] = *(const f32x4*)cp; r.c1[j] = *(const f32x4*)(cp + 4); r.s0[j] = *(const f32x4*)sp; r.s1[j] = *(const f32x4*)(sp + 4);
        r.vv[j] = *(const u32x4*)(projA + (row0 + row) * 8192 + 2048 + hh * 256 + 64 * es + ch * 8);
    }
}
DI void st_commit(const StRaw& r, LAS unsigned char* Kz, LAS unsigned char* Vz, float log2g, int tid) {
#pragma unroll
    for (int j = 0; j < 2; ++j) {
        const int c = tid + NT * j, row = c >> 3, ch = c & 7;
        const float f = 0.08838834764831845f * exp2f((float)(127 - row) * log2g);
        const u32x4 a = r.ka[j], b = r.kb[j]; const f32x4 c0 = r.c0[j], c1 = r.c1[j], s0 = r.s0[j], s1 = r.s1[j];
        u32x4 o1, o2;
#pragma unroll
        for (int k = 0; k < 4; ++k) {
            const float x1a = bflo(a[k]), x1b = bfhi(a[k]), x2a = bflo(b[k]), x2b = bfhi(b[k]);
            const float ca = (k < 2) ? c0[2 * k] : c1[2 * k - 4], cb = (k < 2) ? c0[2 * k + 1] : c1[2 * k - 3];
            const float sa = (k < 2) ? s0[2 * k] : s1[2 * k - 4], sb = (k < 2) ? s0[2 * k + 1] : s1[2 * k - 3];
            o1[k] = pk2((x1a * ca - x2a * sa) * f, (x1b * cb - x2b * sb) * f);
            o2[k] = pk2((x1a * sa + x2a * ca) * f, (x1b * sb + x2b * cb) * f);
        }
        *(LAS u32x4*)(Kz + row * 320 + ch * 16) = o1;
        *(LAS u32x4*)(Kz + row * 320 + 128 + ch * 16) = o2;
        *(LAS u32x4*)(Vz + row * 192 + ch * 16) = r.vv[j];
    }
}
DI void ret_state_item(LAS unsigned char* lds, const bf16_t* projA, bf16_t* rprev, const float* cosT, const float* sinT, int item, int tid) {
    asm volatile("" : "+v"(tid)); __builtin_assume(tid >= 0 && tid < NT);
    const int lane = tid & 63, w = __builtin_amdgcn_readfirstlane(tid >> 6), h = lane >> 5, blk = (lane >> 4) & 1, q4 = (lane & 15) >> 2, p4 = lane & 3;
    const int es = item & 3, hh = (item >> 2) & 7, b = item >> 5;
    const int et = w & 1, dt = w >> 1;
    const float log2g = log2f(1.f - exp2f(-5.f - (float)hh));
    const float gchunk = exp2f(128.f * log2g);
    f32x16 acc = zero16();
    StRaw raw;
    st_issue(raw, projA, cosT, sinT, b, hh, es, 0, tid);
#pragma unroll 1
    for (int n = 0; n < 32; ++n) {
        bf16_t* rp = rprev + ((size_t)((b * 8 + hh) * 32 + n) * 256 + 64 * es + 32 * et) * 128 + 32 * dt + (lane & 31);
#pragma unroll
        for (int i = 0; i < 16; ++i) rp[(size_t)crow(i, h) * 128] = (bf16_t)(pk2(acc[i], 0.f) & 0xffffu);
        if (n == 31) break;
        LAS unsigned char* Kz = lds + (n & 1) * 65536;
        LAS unsigned char* Vz = Kz + 128 * 320;
        st_commit(raw, Kz, Vz, log2g, tid);
        if (n < 30) st_issue(raw, projA, cosT, sinT, b, hh, es, n + 1, tid);
        __syncthreads();
#pragma unroll
        for (int i = 0; i < 16; ++i) acc[i] *= gchunk;
#pragma unroll
        for (int ks = 0; ks < 8; ++ks) {
            const int r0 = 16 * ks + 8 * h + q4;
            const bf16x8 a = tr_pair(Vz + r0 * 192 + (32 * et + 16 * blk + 4 * p4) * 2, Vz + (r0 + 4) * 192 + (32 * et + 16 * blk + 4 * p4) * 2);
            const bf16x8 bb = tr_pair(Kz + r0 * 320 + (32 * dt + 16 * blk + 4 * p4) * 2, Kz + (r0 + 4) * 320 + (32 * dt + 16 * blk + 4 * p4) * 2);
            acc = MFMA32(a, bb, acc);
        }
    }
    __syncthreads();
}

DI void ret_out_item(LAS unsigned char* lds, const bf16_t* projA, const bf16_t* rprev, bf16_t* mix, const float* cosT, const float* sinT, int item, int tid) {
    asm volatile("" : "+v"(tid)); __builtin_assume(tid >= 0 && tid < NT);
    const int lane = tid & 63, w = __builtin_amdgcn_readfirstlane(tid >> 6), h = lane >> 5, blk = (lane >> 4) & 1, q4 = (lane & 15) >> 2, p4 = lane & 3, ql = lane & 31;
    const int n = item & 31, hh = (item >> 5) & 7, b = item >> 8;
    const int qsub = w & 3, eh = w >> 2;
    const float log2g = log2f(1.f - exp2f(-5.f - (float)hh));
    LAS unsigned char* Qs = lds;
    LAS unsigned char* Ks = lds + 34816;
    LAS unsigned char* Rs = lds + 69632;
    LAS unsigned char* Vs = lds;
    LAS float* red = (LAS float*)(lds + 139264);
    const size_t row0 = (size_t)b * SEQ + n * 128;
    __syncthreads();
    load_rot<false>(Qs, 272, projA + row0 * 8192 + hh * 128, 8192, cosT, sinT, n * 128, 1.f, 0.f, tid);
    load_rot<false>(Ks, 272, projA + row0 * 8192 + 1024 + hh * 128, 8192, cosT, sinT, n * 128, 0.08838834764831845f, 0.f, tid);
    load_rows<8, 16>(Rs, 272, rprev + (size_t)((b * 8 + hh) * 32 + n) * 256 * 128, 128, 0, tid);
    __syncthreads();
    bf16x8 qf[8];
#pragma unroll
    for (int ks = 0; ks < 8; ++ks) qf[ks] = *(const LAS bf16x8*)(Qs + (32 * qsub + ql) * 272 + (16 * ks + 8 * h) * 2);
    bf16x8 pf[4][2];
#pragma unroll
    for (int kt = 0; kt < 4; ++kt) {
        if (kt <= qsub) {
            f32x16 s = zero16();
#pragma unroll
            for (int ks = 0; ks < 8; ++ks) { const bf16x8 a = *(const LAS bf16x8*)(Ks + (32 * kt + ql) * 272 + (16 * ks + 8 * h) * 2); s = MFMA32(a, qf[ks], s); }
#pragma unroll
            for (int i = 0; i < 16; ++i) { const int dq = (32 * qsub + ql) - (32 * kt + crow(i, h)); s[i] = (dq >= 0) ? s[i] * __builtin_amdgcn_exp2f((float)dq * log2g) : 0.f; }
            pf[kt][0] = pack8<0>(s); pf[kt][1] = pack8<1>(s);
            __builtin_amdgcn_sched_barrier(0);
        } else { pf[kt][0] = (bf16x8){0, 0, 0, 0, 0, 0, 0, 0}; pf[kt][1] = pf[kt][0]; }
    }
    f32x16 o[4];
    const float xi = exp2f((float)(32 * qsub + ql + 1) * log2g);
#pragma unroll
    for (int et = 0; et < 4; ++et) {
        o[et] = zero16();
#pragma unroll
        for (int ks = 0; ks < 8; ++ks) { const bf16x8 a = *(const LAS bf16x8*)(Rs + (128 * eh + 32 * et + ql) * 272 + (16 * ks + 8 * h) * 2); o[et] = MFMA32(a, qf[ks], o[et]); }
#pragma unroll
        for (int i = 0; i < 16; ++i) o[et][i] *= xi;
    }
    __syncthreads();
    load_rows<8, 32>(Vs, 576, projA + row0 * 8192 + 2048 + hh * 256, 8192, 0, tid);
    __syncthreads();
#pragma unroll
    for (int et = 0; et < 4; ++et)
#pragma unroll
        for (int kt = 0; kt < 4; ++kt)
            if (kt <= qsub) {
#pragma unroll
                for (int s = 0; s < 2; ++s) {
                    const int r0 = 32 * kt + 16 * s + 4 * h + q4; const int cb = (128 * eh + 32 * et + 16 * blk + 4 * p4) * 2;
                    const bf16x8 a = tr_pair(Vs + r0 * 576 + cb, Vs + (r0 + 8) * 576 + cb);
                    o[et] = MFMA32(a, pf[kt][s], o[et]);
                }
            }
    float ss = 0.f;
#pragma unroll
    for (int et = 0; et < 4; ++et)
#pragma unroll
        for (int i = 0; i < 16; ++i) ss += o[et][i] * o[et][i];
    ss += __shfl_xor(ss, 32);
    if (h == 0) red[eh * 128 + 32 * qsub + ql] = ss;
    __syncthreads();
    const float tot = red[32 * qsub + ql] + red[128 + 32 * qsub + ql];
    const float rstd = rsqrtf(tot * (1.f / 256.f) + EPS);
    const size_t tok = row0 + 32 * qsub + ql;
    const bf16_t* gp = projA + tok * 8192 + 4096 + hh * 256 + 128 * eh + 4 * h;
    bf16_t* op = mix + tok * 3072 + hh * 256 + 128 * eh + 4 * h;
#pragma unroll
    for (int et = 0; et < 4; ++et)
#pragma unroll
        for (int i4 = 0; i4 < 4; ++i4) {
            const u32x2 gv = *(const u32x2*)(gp + 32 * et + 8 * i4);
            u32x2 wv;
            wv.x = pk2(o[et][4 * i4] * rstd * silu_f(bflo(gv.x)), o[et][4 * i4 + 1] * rstd * silu_f(bfhi(gv.x)));
            wv.y = pk2(o[et][4 * i4 + 2] * rstd * silu_f(bflo(gv.y)), o[et][4 * i4 + 3] * rstd * silu_f(bfhi(gv.y)));
            *(u32x2*)(op + 32 * et + 8 * i4) = wv;
        }
}

DI void mem_attn_item(LAS unsigned char* lds, const bf16_t* qp, size_t ldq, const bf16_t* gatep, size_t ldg, bf16_t* outp, size_t ldo,
                      const bf16_t* kmem, const bf16_t* vmem, int tid, bool dry = false) {
    asm volatile("" : "+v"(tid)); __builtin_assume(tid >= 0 && tid < NT);
    const int lane = tid & 63, w = __builtin_amdgcn_readfirstlane(tid >> 6), h = lane >> 5, blk = (lane >> 4) & 1, q4 = (lane & 15) >> 2, p4 = lane & 3, ql = lane & 31;
    LAS unsigned char* Ks = lds;
    LAS unsigned char* Vs = lds;
    __syncthreads();
    load_rows<16, 32>(Ks, 528, kmem, 8192, 0, tid);
    __syncthreads();
    const bf16_t* qrow = qp + (size_t)(32 * w + ql) * ldq + 8 * h;
    f32x16 s[8];
#pragma unroll
    for (int kt = 0; kt < 8; ++kt) s[kt] = zero16();
#pragma unroll
    for (int dh = 0; dh < 2; ++dh) {
        bf16x8 qf[8];
#pragma unroll
        for (int ks = 0; ks < 8; ++ks) qf[ks] = *(const bf16x8*)(qrow + 128 * dh + 16 * ks);
#pragma unroll
        for (int kt = 0; kt < 8; ++kt)
#pragma unroll
            for (int ks = 0; ks < 8; ++ks) { const bf16x8 a = *(const LAS bf16x8*)(Ks + (32 * kt + ql) * 528 + (128 * dh + 16 * ks + 8 * h) * 2); s[kt] = MFMA32(a, qf[ks], s[kt]); }
    }
    const float c = 0.0625f * LOG2E;
    float m = -3.0e38f;
#pragma unroll
    for (int kt = 0; kt < 8; ++kt)
#pragma unroll
        for (int i = 0; i < 16; ++i) { s[kt][i] *= c; m = fmaxf(m, s[kt][i]); }
    m = fmaxf(m, __shfl_xor(m, 32));
    float l = 0.f;
    bf16x8 pf[8][2];
#pragma unroll
    for (int kt = 0; kt < 8; ++kt) {
#pragma unroll
        for (int i = 0; i < 16; ++i) { s[kt][i] = __builtin_amdgcn_exp2f(s[kt][i] - m); l += s[kt][i]; }
        pf[kt][0] = pack8<0>(s[kt]); pf[kt][1] = pack8<1>(s[kt]);
        __builtin_amdgcn_sched_barrier(0);
    }
    l += __shfl_xor(l, 32);
    const float rl = 1.f / l;
#pragma unroll
    for (int eh = 0; eh < 2; ++eh) {
        __syncthreads();
        load_rows<8, 16>(Vs, 320, vmem + 128 * eh, 8192, 0, tid);
        __syncthreads();
        f32x16 o[4];
#pragma unroll
        for (int et = 0; et < 4; ++et) {
            o[et] = zero16();
#pragma unroll
            for (int kt = 0; kt < 8; ++kt)
#pragma unroll
                for (int sx = 0; sx < 2; ++sx) {
                    const int r0 = 32 * kt + 16 * sx + 4 * h + q4; const int cb = (32 * et + 16 * blk + 4 * p4) * 2;
                    const bf16x8 a = tr_pair(Vs + r0 * 320 + cb, Vs + (r0 + 8) * 320 + cb);
                    o[et] = MFMA32(a, pf[kt][sx], o[et]);
                }
        }
        const bf16_t* gp = gatep + (size_t)(32 * w + ql) * ldg + 128 * eh + 4 * h;
        bf16_t* op = outp + (size_t)(32 * w + ql) * ldo + 128 * eh + 4 * h;
#pragma unroll
        for (int et = 0; et < 4; ++et)
#pragma unroll
            for (int i4 = 0; i4 < 4; ++i4) {
                const u32x2 gv = *(const u32x2*)(gp + 32 * et + 8 * i4);
                u32x2 wv;
                wv.x = pk2(o[et][4 * i4] * rl * silu_f(bflo(gv.x)), o[et][4 * i4 + 1] * rl * silu_f(bfhi(gv.x)));
                wv.y = pk2(o[et][4 * i4 + 2] * rl * silu_f(bflo(gv.y)), o[et][4 * i4 + 3] * rl * silu_f(bfhi(gv.y)));
                if (!dry) *(u32x2*)(op + 32 * et + 8 * i4) = wv;
            }
    }
}

DI void dil_attn_item(LAS unsigned char* lds, bf16_t* qp, size_t ldq, const bf16_t* kp, const bf16_t* vp, float* lsep  , int i0, int tid, bool dry = false) {
    asm volatile("" : "+v"(tid)); __builtin_assume(tid >= 0 && tid < NT);
    const int lane = tid & 63, w = __builtin_amdgcn_readfirstlane(tid >> 6), h = lane >> 5, blk = (lane >> 4) & 1, q4 = (lane & 15) >> 2, p4 = lane & 3, ql = lane & 31;
    LAS unsigned char* Ks = lds;
    LAS unsigned char* Vs = lds;
    const int zr = (i0 == 0) ? 128 : 0;
    __syncthreads();
    load_rows<12, 16>(Ks, 272, kp - (ptrdiff_t)128 * 128, 128, zr, tid);
    bf16x8 qf[8];
    bf16_t* qrow = qp + (size_t)(32 * w + ql) * ldq;
#pragma unroll
    for (int ks = 0; ks < 8; ++ks) qf[ks] = *(const bf16x8*)(qrow + 16 * ks + 8 * h);
    __syncthreads();
    u32x4 vreg[12];
    ld_issue<12, 16>(vreg, vp - (ptrdiff_t)128 * 128, 128, zr, tid);
    __builtin_amdgcn_sched_barrier(0);
    f32x16 s[5];
#pragma unroll
    for (int kt = 0; kt < 5; ++kt) {
        s[kt] = zero16();
#pragma unroll
        for (int ks = 0; ks < 8; ++ks) { const bf16x8 a = *(const LAS bf16x8*)(Ks + (32 * w + 32 * kt + ql) * 272 + (16 * ks + 8 * h) * 2); s[kt] = MFMA32(a, qf[ks], s[kt]); }
    }
    const float c = 0.08838834764831845f * LOG2E;
    float m = -3.0e38f;
#pragma unroll
    for (int kt = 0; kt < 5; ++kt)
#pragma unroll
        for (int i = 0; i < 16; ++i) {
            const int kr = crow(i, h);
            bool valid = true;
            if (kt == 0) valid = (kr >= ql);
            if (kt == 4) valid = (kr <= ql);
            if (zr) valid = valid && (32 * w + 32 * kt + kr >= 128);
            s[kt][i] = valid ? s[kt][i] * c : -3.0e38f;
            m = fmaxf(m, s[kt][i]);
        }
    m = fmaxf(m, __shfl_xor(m, 32));
    float l = 0.f;
    bf16x8 pf[5][2];
#pragma unroll
    for (int kt = 0; kt < 5; ++kt) {
#pragma unroll
        for (int i = 0; i < 16; ++i) { s[kt][i] = __builtin_amdgcn_exp2f(s[kt][i] - m); l += s[kt][i]; }
        pf[kt][0] = pack8<0>(s[kt]); pf[kt][1] = pack8<1>(s[kt]);
        __builtin_amdgcn_sched_barrier(0);
    }
    l += __shfl_xor(l, 32);
    const float rl = 1.f / l;
    __syncthreads();
    ld_commit<12, 16>(Vs, 320, vreg, tid);
    __syncthreads();
    f32x16 o[4];
#pragma unroll
    for (int dt = 0; dt < 4; ++dt) {
        o[dt] = zero16();
#pragma unroll
        for (int kt = 0; kt < 5; ++kt)
#pragma unroll
            for (int sx = 0; sx < 2; ++sx) {
                const int r0 = 32 * w + 32 * kt + 16 * sx + 4 * h + q4; const int cb = (32 * dt + 16 * blk + 4 * p4) * 2;
                const bf16x8 a = tr_pair(Vs + r0 * 320 + cb, Vs + (r0 + 8) * 320 + cb);
                o[dt] = MFMA32(a, pf[kt][sx], o[dt]);
            }
    }
#pragma unroll
    for (int dt = 0; dt < 4; ++dt)
#pragma unroll
        for (int i4 = 0; i4 < 4; ++i4) {
            u32x2 wv; wv.x = pk2(o[dt][4 * i4] * rl, o[dt][4 * i4 + 1] * rl); wv.y = pk2(o[dt][4 * i4 + 2] * rl, o[dt][4 * i4 + 3] * rl);
            if (!dry) *(u32x2*)(qrow + 32 * dt + 8 * i4 + 4 * h) = wv;
        }
    if (h == 0 && !dry) lsep[(size_t)(32 * w + ql) * 16] = m * LN2 + __logf(l);
}

#define XB_TMO      128
#define XB_XCNT(j)  (256  + 64 * (j))
#define XB_XSUB(j)  (1280 + 64 * (j))
#define XB_XGEN(j)  (2304 + 64 * (j))
#define XB_TOP      3328
#define XB_TOPGEN   3392
#define XCD_BAR_WORDS 3456
#define XB_SPIN_CAP (1u << 18)

__device__ __forceinline__ unsigned xb_ld(unsigned* p)              { return __hip_atomic_load(p, __ATOMIC_RELAXED, __HIP_MEMORY_SCOPE_AGENT); }
__device__ __forceinline__ unsigned xb_add(unsigned* p, unsigned v) { return __hip_atomic_fetch_add(p, v, __ATOMIC_RELAXED, __HIP_MEMORY_SCOPE_AGENT); }
__device__ __forceinline__ unsigned xb_xcc_id() { return (unsigned)__builtin_amdgcn_s_getreg((3 << 11) | 20) & 0xFu; }
#define XB_SPIN(cond, bar) do { unsigned _sp = 0; while (cond) { __builtin_amdgcn_s_sleep(1); \
    if ((++_sp & 255u) == 0u) { if (xb_ld(&(bar)[XB_TMO])) break; if (_sp > XB_SPIN_CAP) { atomicAdd(&(bar)[XB_TMO], 1u); break; } } } } while (0)

struct XcdBarrier {
    unsigned* bar; unsigned x;
    volatile LAS unsigned* st;
};

__device__ __forceinline__ XcdBarrier xcd_barrier_post(unsigned* bar, volatile LAS unsigned* st) {
    XcdBarrier b; b.bar = bar; b.x = xb_xcc_id(); b.st = st;
    if (threadIdx.x == 0) (void)xb_add(&bar[XB_XCNT(b.x)], 1u);
    return b;
}
__device__ __forceinline__ void xcd_barrier_complete(unsigned* bar, unsigned x, unsigned& nloc, unsigned& nx) {
    const unsigned G = gridDim.x * gridDim.y * gridDim.z;
    unsigned sum, cnt, mine, sp = 0u;
    for (;;) {
        sum = 0u; cnt = 0u; mine = 0u;
#pragma unroll
        for (unsigned j = 0; j < 16; ++j) { const unsigned c = xb_ld(&bar[XB_XCNT(j)]); sum += c; cnt += (c > 0u) ? 1u : 0u; mine = (j == x) ? c : mine; }
        if (sum == G) break;
        __builtin_amdgcn_s_sleep(1);
        if ((++sp & 255u) == 0u) { if (xb_ld(&bar[XB_TMO])) break; if (sp > XB_SPIN_CAP) { atomicAdd(&bar[XB_TMO], 1u); break; } }
    }
    nloc = mine > 0u ? mine : 1u; nx = cnt > 0u ? cnt : 1u;
}

__device__ __forceinline__ void xcd_barrier(const XcdBarrier& b) {
    asm volatile("s_waitcnt vmcnt(0)" ::: "memory");
    __syncthreads();
    if (threadIdx.x == 0) {
        unsigned* bar = b.bar;
        __builtin_amdgcn_s_waitcnt(0);
        unsigned nloc = b.st[0], nx = b.st[1];
        if (nloc == 0u) { xcd_barrier_complete(bar, b.x, nloc, nx); b.st[0] = nloc; b.st[1] = nx; }
        const unsigned old = xb_add(&bar[XB_XSUB(b.x)], 1u);
        const unsigned gen = old / nloc;
        if (old + 1u == (gen + 1u) * nloc) {
            __builtin_amdgcn_fence(__ATOMIC_RELEASE, "agent");
            asm volatile("s_waitcnt vmcnt(0)" ::: "memory");
            const unsigned og = xb_add(&bar[XB_TOP], 1u);
            const unsigned tg = og / nx;
            if (og + 1u == (tg + 1u) * nx) xb_add(&bar[XB_TOPGEN], 1u);
            else XB_SPIN(xb_ld(&bar[XB_TOPGEN]) == tg, bar);
            __builtin_amdgcn_fence(__ATOMIC_ACQUIRE, "agent");
            xb_add(&bar[XB_XGEN(b.x)], 1u);
            asm volatile("s_waitcnt vmcnt(0)" ::: "memory");
        } else {
            XB_SPIN(xb_ld(&bar[XB_XGEN(b.x)]) == gen, bar);
            __builtin_amdgcn_fence(__ATOMIC_ACQUIRE, "agent");
            asm volatile("s_waitcnt vmcnt(0)" ::: "memory");
        }
    }
    __syncthreads();
}


struct Params {
    const float *x, *mem, *norm_a, *w_in_a, *w_out_a, *norm_b, *w_in_b, *w_out_b, *w_mem_kv, *mem_norm_g, *kv_norm_g, *w_kv, *final_norm_g;
    float* out; unsigned char* ws; int ph_lo, ph_hi;
};
enum { K_PRO = 0, K_A_GEMM, K_A_STATE, K_A_RETOUT, K_A_OUT, K_KV, K_B_GEMM, K_B_ATTN, K_B_MERGE, K_B_OUT, K_FINAL };
enum { T_NONE = 0, T_PRO, T_A0_STATE, T_A1_STATE, T_A1_OUT, T_KV, T_B0H1_ATTN, T_B1H0_GEMM };

struct TrJob { const float* W; int K, N, nsrc0, ncols; bf16_t* WT; int drow0; };
DI bool tr_job(const Params& p, unsigned char* ws, int tag, int j, TrJob& t) {
    bf16_t* Win = (bf16_t*)(ws + WS_WIN); bf16_t* Wout = (bf16_t*)(ws + WS_WOUT);
    if (tag == T_PRO) {
        if (j == 0) { t = TrJob{p.w_in_a, 2048, 8192, 0, 8192, Win, 0}; return true; }
        if (j == 1) { t = TrJob{p.w_out_a, 3072, 2048, 0, 2048, Wout, 0}; return true; }
        if (j < 6) { t = TrJob{p.w_mem_kv + (size_t)(j - 2) * 2048 * 2048, 2048, 2048, 0, 2048, (bf16_t*)(ws + WS_WMEMT), (j - 2) * 2048}; return true; }
        return false;
    }
    if (tag == T_A0_STATE) { if (j == 0) { t = TrJob{p.w_in_a + (size_t)2048 * 8192, 2048, 8192, 0, 8192, Win, 0}; return true; } return false; }
    if (tag == T_A1_OUT) { if (j == 0) { t = TrJob{p.w_kv, 2048, 12288, 0, 12288, (bf16_t*)(ws + WS_WKVT), 0}; return true; } return false; }
    if (tag == T_KV) { if (j == 0) { t = TrJob{p.w_out_b, 3072, 2048, 0, 2048, Wout, 0}; return true; } return false; }
    if (tag == T_B1H0_GEMM) { if (j == 0) { t = TrJob{p.w_out_b + (size_t)3072 * 2048, 3072, 2048, 0, 2048, Wout, 0}; return true; } return false; }
    if (tag == T_A1_STATE || tag == T_B0H1_ATTN) {
        const float* wi = p.w_in_b + (tag == T_A1_STATE ? 0 : (size_t)2048 * 10240);
        switch (j) {
            case 0: t = TrJob{wi, 2048, 10240, 0, 2048, Win, 0}; return true;
            case 1: t = TrJob{wi, 2048, 10240, 8192, 1024, Win, 2048}; return true;
            case 2: t = TrJob{wi, 2048, 10240, 9216, 1024, Win, 3072}; return true;
            case 3: t = TrJob{wi, 2048, 10240, 6144, 2048, Win, 4096}; return true;
            case 4: t = TrJob{wi, 2048, 10240, 2048, 2048, Win, 6144}; return true;
            case 5: t = TrJob{wi, 2048, 10240, 4096, 2048, Win, 8192}; return true;
            case 6: if (tag == T_A1_STATE) { t = TrJob{p.w_out_a + (size_t)3072 * 2048, 3072, 2048, 0, 2048, Wout, 0}; return true; } return false;
            default: return false;
        }
    }
    return false;
}
DI bool gemm_job(const Params& p, unsigned char* ws, int kind, int la, int lb, int hb, int j, int G, int bid, pg8::Gemm& g, pg8::EpiBf16& E, int& c) {
    c = bid;
    bf16_t* Win = (bf16_t*)(ws + WS_WIN); const float* SS = (const float*)(ws + WS_SS);
    if (kind == K_A_GEMM) {
        if (j == 0) { g = pg8::Gemm{(bf16_t*)(ws + WS_HA), Win, T_TOK, 8192, 2048, 2048, 1}; E = pg8::EpiBf16{(bf16_t*)(ws + WS_PROJA), 8192, 0, la == 0 ? nullptr : SS, 1}; return true; }
        if (j == 1 && la == 0) { g = pg8::Gemm{(bf16_t*)(ws + WS_MEMN), (bf16_t*)(ws + WS_WMEMT), 1024, 8192, 2048, 2048, 1}; E = pg8::EpiBf16{(bf16_t*)(ws + WS_MEMKV), 8192, 0, nullptr, 1}; c = (bid + G / 2) % G; return true; }
        return false;
    }
    if (kind == K_KV) {
        if (j >= 3) return false;
        const int dil = (j == 0) ? 1 : (j == 1 ? 4 : 16);
        g = pg8::Gemm{(bf16_t*)(ws + WS_HA), (bf16_t*)(ws + WS_WKVT) + (size_t)j * 4096 * 2048, T_TOK, 4096, 2048, 2048, dil};
        E = pg8::EpiBf16{(bf16_t*)(ws + WS_KV) + (size_t)j * T_TOK * 4096, 4096, 1, SS + T_TOK, dil}; return true;
    }
    if (kind == K_B_GEMM) {
        bf16_t* hB = (bf16_t*)(ws + WS_HB) + (size_t)hb * 8192 * DM; bf16_t* projB = (bf16_t*)(ws + WS_P);
        const float* ssb = SS + (size_t)(1 + lb) * T_TOK + (size_t)hb * 8192;
        if (j == 0) { g = pg8::Gemm{hB, Win, 8192, 6144, 2048, 2048, 1}; E = pg8::EpiBf16{projB, 10240, 0, ssb, 1}; return true; }
        if (j == 1) { g = pg8::Gemm{hB, Win + (size_t)6144 * 2048, 8192, 2048, 2048, 2048, 4}; E = pg8::EpiBf16{projB + 6144, 10240, 0, ssb, 4}; return true; }
        if (j == 2) { g = pg8::Gemm{hB, Win + (size_t)8192 * 2048, 8192, 2048, 2048, 2048, 16}; E = pg8::EpiBf16{projB + 8192, 10240, 0, ssb, 16}; return true; }
        return false;
    }
    return false;
}

__global__ void __launch_bounds__(NT, 2) yoco_fwd(Params p) {
    extern __shared__ __attribute__((aligned(16))) unsigned char lds_raw[];
    LAS unsigned char* lds = (LAS unsigned char*)lds_raw;
    const int bid = blockIdx.x;
    volatile LAS unsigned* bst = (volatile LAS unsigned*)(lds + LDS_BYTES - 16);
    if (threadIdx.x < 2) bst[threadIdx.x] = 0u;
    __syncthreads();
    (void)xcd_barrier_post((unsigned*)(p.ws + WS_BAR), bst);
#pragma unroll 1
    for (int ph = p.ph_lo; ph < p.ph_hi; ++ph) {
        int tid = threadIdx.x;
        asm volatile("" : "+v"(tid)); __builtin_assume(tid >= 0 && tid < NT);
        const int lane = tid & 63, wave = __builtin_amdgcn_readfirstlane(tid >> 6);
        int G = gridDim.x; asm volatile("" : "+s"(G));
        const int gw = bid * 8 + wave, ngw = G * 8;
        unsigned char* ws = p.ws; asm volatile("" : "+s"(ws));
        int kind, la = 0, lb = 0, hb = 0;
        if (ph == 0) kind = K_PRO;
        else if (ph <= 8) { la = (ph - 1) / 4; kind = K_A_GEMM + (ph - 1) % 4; }
        else if (ph == 9) kind = K_KV;
        else if (ph <= 25) { const int idx = ph - 10; lb = idx / 8; hb = (idx / 4) % 2; kind = K_B_GEMM + idx % 4; }
        else kind = K_FINAL;
        int ttag = T_NONE, tgw = gw, tngw = ngw; bool t_first = false;
        if (kind == K_PRO) { ttag = T_PRO; t_first = true; }
        else if (kind == K_A_STATE) { ttag = (la == 0) ? T_A0_STATE : T_A1_STATE; if (G >= 256) { tgw = (bid - 128) * 8 + wave; tngw = (G - 128) * 8; if (bid < 128) ttag = T_NONE; } }
        else if (kind == K_A_OUT && la == 1) ttag = T_A1_OUT;
        else if (kind == K_KV) ttag = T_KV;
        else if (kind == K_B_ATTN && lb == 0 && hb == 1) ttag = T_B0H1_ATTN;
        else if (kind == K_B_GEMM && lb == 1 && hb == 0) ttag = T_B1H0_GEMM;

        if (kind == K_PRO) {
            norm_rows(p.mem, p.mem_norm_g, (bf16_t*)(ws + WS_MEMN), 1024, gw, ngw, lane);
            float* cosT = (float*)(ws + WS_COS); float* sinT = (float*)(ws + WS_SIN); float* SSw = (float*)(ws + WS_SS);
            for (int i = bid * NT + tid; i < 4096 * 64; i += G * NT) { const int pos = i >> 6, j = i & 63;
                const float inv = 1.0f / powf(10000.0f, (float)j * (1.0f / 63.0f)); const float ang = (float)pos * inv;
                cosT[i] = cosf(ang); sinT[i] = sinf(ang); }
            for (int i = bid * NT + tid; i < 3 * T_TOK; i += G * NT) SSw[i] = 0.f;
            norm_rows(p.x, p.norm_a, (bf16_t*)(ws + WS_HA), T_TOK, gw, ngw, lane);
        }
        if (kind == K_A_GEMM || kind == K_KV || kind == K_B_GEMM) {
            pg8::Gemm g; pg8::EpiBf16 E; int c;
#pragma unroll 1
            for (int j = 0; gemm_job(p, ws, kind, la, lb, hb, j, G, bid, g, E, c); ++j) { pg8::StaticOrder S; S.init(g.M, g.N, G, c); pg8::gemm_phase(lds, g, S, E); }
        }
        if (kind == K_A_OUT || kind == K_B_OUT) {
            pg8::Gemm g; pg8::EpiRes E; float* SSw = (float*)(ws + WS_SS);
            if (kind == K_A_OUT) {
                g = pg8::Gemm{(bf16_t*)(ws + WS_MIXA), (bf16_t*)(ws + WS_WOUT), T_TOK, 2048, 3072, 3072, 1};
                if (la == 0) E = pg8::EpiRes{p.x, p.out, p.norm_a + 2048, (bf16_t*)(ws + WS_HA), nullptr, nullptr, SSw};
                else E = pg8::EpiRes{p.out, p.out, p.kv_norm_g, (bf16_t*)(ws + WS_HA), p.norm_b, (bf16_t*)(ws + WS_HB), SSw + T_TOK};
            } else {
                float* xh = p.out + (size_t)hb * 8192 * DM;
                g = pg8::Gemm{(bf16_t*)(ws + WS_P), (bf16_t*)(ws + WS_WOUT), 8192, 2048, 3072, 10240, 1};
                if (lb == 0) E = pg8::EpiRes{xh, xh, p.norm_b + 2048, (bf16_t*)(ws + WS_HB) + (size_t)hb * 8192 * DM, nullptr, nullptr, SSw + 2 * T_TOK + (size_t)hb * 8192};
                else E = pg8::EpiRes{xh, xh, nullptr, nullptr, nullptr, nullptr, nullptr};
            }
            pg8::StaticOrder S; S.init(g.M, g.N, G, bid); pg8::gemm_phase(lds, g, S, E);
        }
        if (kind == K_A_STATE) {
#pragma unroll 1
            for (int it = bid; it < 128; it += G) { __syncthreads(); ret_state_item(lds, (bf16_t*)(ws + WS_PROJA), (bf16_t*)(ws + WS_RPREV), (float*)(ws + WS_COS), (float*)(ws + WS_SIN), it, tid); }
        }
        if (kind == K_B_ATTN) {
            bf16_t* projB = (bf16_t*)(ws + WS_P); float* lse = (float*)(ws + WS_LSE);
#pragma unroll 1
            for (int it = bid; it < 1536; it += G) {
                const int head = it & 15, blkr = (it >> 4) & 31, gi = it >> 9;
                const int n = (gi == 0) ? 4096 : (gi == 1 ? 1024 : 256);
                const int colq = (gi == 0) ? 0 : (gi == 1 ? 6144 : 8192);
                const int ml0 = blkr * 256, i0 = (ml0 & 4095) % n; const size_t mg0 = (size_t)hb * 8192 + ml0;
                const bf16_t* kvg = (bf16_t*)(ws + WS_KV) + (size_t)gi * T_TOK * 4096;
                dil_attn_item(lds, projB + (size_t)ml0 * 10240 + colq + head * 128, 10240, kvg + ((size_t)head * T_TOK + mg0) * 128, kvg + ((size_t)(16 + head) * T_TOK + mg0) * 128,
                              lse + ((size_t)gi * 8192 + ml0) * 16 + head, i0, tid);
            }
        }
        if (kind == K_A_STATE || kind == K_B_ATTN) {
            const bool isA = (kind == K_A_STATE);
            const int nit = isA ? 256 : 128;
            const int first = (isA && G >= 256) ? 128 : 0;
            const bf16_t* memKV = (bf16_t*)(ws + WS_MEMKV);
            if (bid >= first) {
#pragma unroll 1
                for (int it = bid - first; it < nit; it += G - first) {
                    const int mh = it & 3, blkr = it >> 2; const size_t row0 = (size_t)blkr * 256;
                    const int b = isA ? (blkr >> 4) : (hb * 2 + (blkr >> 4)); const int layer = isA ? la : 2 + lb;
                    const bf16_t* km = memKV + (size_t)b * 256 * 8192 + layer * 2048 + mh * 256;
                    const bf16_t* qp; const bf16_t* gp; bf16_t* op; size_t ldq, ldo;
                    if (isA) { const bf16_t* pa = (bf16_t*)(ws + WS_PROJA) + row0 * 8192; qp = pa + 6144 + mh * 256; gp = pa + 7168 + mh * 256; ldq = 8192; op = (bf16_t*)(ws + WS_MIXA) + row0 * 3072 + 2048 + mh * 256; ldo = 3072; }
                    else { bf16_t* pb = (bf16_t*)(ws + WS_P) + row0 * 10240; qp = pb + 2048 + mh * 256; gp = pb + 3072 + mh * 256; ldq = 10240; op = pb + 2048 + mh * 256; ldo = 10240; }
                    mem_attn_item(lds, qp, ldq, gp, ldq, op, ldo, km, km + 1024, tid);
                }
            }
        }
        if (kind == K_A_RETOUT) {
#pragma unroll 1
            for (int it = bid; it < 1024; it += G) ret_out_item(lds, (bf16_t*)(ws + WS_PROJA), (bf16_t*)(ws + WS_RPREV), (bf16_t*)(ws + WS_MIXA), (float*)(ws + WS_COS), (float*)(ws + WS_SIN), it, tid);
        }
        if (kind == K_B_MERGE) {
            bf16_t* projB = (bf16_t*)(ws + WS_P); const float* lse = (const float*)(ws + WS_LSE);
#pragma unroll 1
            for (int tl = gw; tl < 8192; tl += ngw) {
                const int b = tl >> 12, ti = tl & 4095;
                const int m1 = b * 4096 + (ti & 3) * 1024 + (ti >> 2), m2 = b * 4096 + (ti & 15) * 256 + (ti >> 4);
                bf16_t* r0 = projB + (size_t)tl * 10240; const bf16_t* r1 = projB + (size_t)m1 * 10240 + 6144; const bf16_t* r2 = projB + (size_t)m2 * 10240 + 8192;
#pragma unroll
                for (int j = 0; j < 4; ++j) {
                    const int col = j * 512 + lane * 8, head = col >> 7;
                    const float l0 = lse[(size_t)tl * 16 + head], l1 = lse[((size_t)8192 + m1) * 16 + head], l2 = lse[((size_t)16384 + m2) * 16 + head];
                    const float mx = fmaxf(l0, fmaxf(l1, l2));
                    float a0 = __expf(l0 - mx), a1 = __expf(l1 - mx), a2 = __expf(l2 - mx); const float rs = 1.f / (a0 + a1 + a2); a0 *= rs; a1 *= rs; a2 *= rs;
                    const u32x4 v0 = *(const u32x4*)(r0 + col), v1 = *(const u32x4*)(r1 + col), v2 = *(const u32x4*)(r2 + col), gv = *(const u32x4*)(r0 + 4096 + col);
                    u32x4 ov;
#pragma unroll
                    for (int k = 0; k < 4; ++k) {
                        const float ea = a0 * bflo(v0[k]) + a1 * bflo(v1[k]) + a2 * bflo(v2[k]), eb = a0 * bfhi(v0[k]) + a1 * bfhi(v1[k]) + a2 * bfhi(v2[k]);
                        ov[k] = pk2(ea * silu_f(bflo(gv[k])), eb * silu_f(bfhi(gv[k])));
                    }
                    *(u32x4*)(r0 + col) = ov;
                }
            }
        }
        if (kind == K_FINAL) {
#pragma unroll 1
            for (int m = gw; m < T_TOK; m += ngw) {
                float* xr = p.out + (size_t)m * DM;
                f32x4 v[8]; float s = 0.f;
#pragma unroll
                for (int j = 0; j < 8; ++j) { v[j] = ((const f32x4*)xr)[lane + 64 * j]; s += (v[j].x * v[j].x + v[j].y * v[j].y) + (v[j].z * v[j].z + v[j].w * v[j].w); }
                const float rstd = rsqrtf(wave_sum(s) * (1.f / DM) + EPS);
#pragma unroll
                for (int j = 0; j < 8; ++j) { const f32x4 gg = ((const f32x4*)p.final_norm_g)[lane + 64 * j]; ((f32x4*)xr)[lane + 64 * j] = v[j] * rstd * gg; }
            }
        }
        if (ttag != T_NONE) {
            __syncthreads();
            LAS float* scr = (LAS float*)(lds + wave * 16640);
            TrJob t;
#pragma unroll 1
            for (int j = 0; tr_job(p, ws, ttag, j, t); ++j) transpose_seg(t.W, t.K, t.N, t.nsrc0, t.ncols, t.WT, t.drow0, scr, tgw, tngw, lane);
        }
        if (ph + 1 < p.ph_hi) {
            if (ph == p.ph_lo) cg::this_grid().sync();
            else { XcdBarrier xb; xb.bar = (unsigned*)(ws + WS_BAR); xb.x = xb_xcc_id(); xb.st = (volatile LAS unsigned*)(lds + LDS_BYTES - 16); xcd_barrier(xb); }
        }
    }
}

constexpr int N_PHASES = 1 + 2 * 4 + 1 + 4 * 4 + 1;

extern "C" void kernel_launch(void* const* d_in, const int* in_sizes, int n_in, void* d_out, int out_size, void* d_ws, size_t ws_size, hipStream_t stream) {
    static int grid = 0;
    if (grid == 0) {
        if (ws_size < WS_END) { fprintf(stderr, "kernel_launch: workspace too small: %zu < %zu\n", ws_size, (size_t)WS_END); grid = -1; return; }
        int dev = 0, cus = 0, per_cu = 0;
        hipGetDevice(&dev);
        hipDeviceGetAttribute(&cus, hipDeviceAttributeMultiprocessorCount, dev);
        if (hipFuncSetAttribute((const void*)yoco_fwd, hipFuncAttributeMaxDynamicSharedMemorySize, LDS_BYTES) != hipSuccess) { fprintf(stderr, "kernel_launch: hipFuncSetAttribute failed\n"); grid = -1; return; }
        if (hipOccupancyMaxActiveBlocksPerMultiprocessor(&per_cu, (const void*)yoco_fwd, NT, LDS_BYTES) != hipSuccess || per_cu < 1) { fprintf(stderr, "kernel_launch: occupancy query gave %d\n", per_cu); per_cu = 1; }
        (void)hipGetLastError();
        grid = cus;
        fprintf(stderr, "kernel_launch: grid %d (cus %d, per_cu %d), ws %zu\n", grid, cus, per_cu, ws_size);
    }
    if (grid < 0) return;
    (void)hipMemsetAsync((char*)d_ws + WS_BAR, 0, 16384, stream);
    Params p{};
    p.x = (const float*)d_in[0]; p.mem = (const float*)d_in[1]; p.norm_a = (const float*)d_in[2]; p.w_in_a = (const float*)d_in[3]; p.w_out_a = (const float*)d_in[4];
    p.norm_b = (const float*)d_in[5]; p.w_in_b = (const float*)d_in[6]; p.w_out_b = (const float*)d_in[7]; p.w_mem_kv = (const float*)d_in[8]; p.mem_norm_g = (const float*)d_in[9];
    p.kv_norm_g = (const float*)d_in[10]; p.w_kv = (const float*)d_in[11]; p.final_norm_g = (const float*)d_in[12];
    p.out = (float*)d_out; p.ws = (unsigned char*)d_ws;
#if MK_SPLIT
    for (int k = 0; k < N_PHASES; ++k) {
        p.ph_lo = k; p.ph_hi = k + 1;
        hipLaunchKernelGGL(yoco_fwd, dim3(grid), dim3(NT), LDS_BYTES, stream, p);
    }
#else
    p.ph_lo = 0; p.ph_hi = N_PHASES;
    void* args[] = {&p};
    hipError_t e = hipLaunchCooperativeKernel((const void*)yoco_fwd, dim3(grid), dim3(NT), args, LDS_BYTES, stream);
    if (e != hipSuccess) fprintf(stderr, "cooperative launch failed: %s (grid %d)\n", hipGetErrorString(e), grid);
#endif
}
```

```cpp
#include <hip/hip_runtime.h>
#include <hip/hip_cooperative_groups.h>
#include <cstdio>
#include <cstdint>
namespace cg = cooperative_groups;

#ifndef MK_SPLIT
#define MK_SPLIT 0
#endif

#ifndef PROBE_TGROUP
#define PROBE_TGROUP 0
#endif
#ifndef PROBE_GEMM
#define PROBE_GEMM 0
#endif
#ifndef PROBE_RET
#define PROBE_RET 0
#endif
#ifndef PROBE_ATTN
#define PROBE_ATTN 0
#endif
#define LAS __attribute__((address_space(3)))
#define GAS __attribute__((address_space(1)))
#define DI __device__ __forceinline__
typedef unsigned short bf16_t;
typedef short bf16x8 __attribute__((ext_vector_type(8)));
typedef short s16x4 __attribute__((ext_vector_type(4)));
typedef float f32x4 __attribute__((ext_vector_type(4)));
typedef float f32x16 __attribute__((ext_vector_type(16)));
typedef unsigned u32x4 __attribute__((ext_vector_type(4)));
typedef unsigned u32x2 __attribute__((ext_vector_type(2)));
typedef __bf16 nbf16x2 __attribute__((ext_vector_type(2)));

constexpr int NT = 512;
constexpr int T_TOK = 16384, DM = 2048, SEQ = 4096;
constexpr int LDS_BYTES = 144 * 1024;
constexpr float EPS = 1e-6f;
constexpr float LOG2E = 1.4426950408889634f, LN2 = 0.6931471805599453f;

constexpr size_t MiB = 1048576;
constexpr size_t WS_KV   = 0;
constexpr size_t WS_PROJA = 0;
constexpr size_t WS_MIXA = 256 * MiB;
constexpr size_t WS_WMEMT = 352 * MiB;
constexpr size_t WS_P    = 384 * MiB;
constexpr size_t WS_HA   = 384 * MiB;
constexpr size_t WS_RPREV = 448 * MiB;
constexpr size_t WS_WKVT = 448 * MiB;
constexpr size_t WS_MEMN = 512 * MiB;
constexpr size_t WS_HB   = 544 * MiB;
constexpr size_t WS_WIN  = 608 * MiB;
constexpr size_t WS_WOUT = 648 * MiB;
constexpr size_t WS_MEMKV = 660 * MiB;
constexpr size_t WS_COS  = 676 * MiB;
constexpr size_t WS_SIN  = 677 * MiB;
constexpr size_t WS_LSE  = 678 * MiB;
constexpr size_t WS_BAR  = 679 * MiB + 512 * 1024;
constexpr size_t WS_SS   = 679 * MiB + 512 * 1024 + 65536;
constexpr size_t WS_END  = 680 * MiB;

DI unsigned pk2(float a, float b) { nbf16x2 v; v[0] = (__bf16)a; v[1] = (__bf16)b; return __builtin_bit_cast(unsigned, v); }
typedef _Float16 f16x2_t __attribute__((ext_vector_type(2)));
DI unsigned pkh2(float a, float b) { f16x2_t v; v[0] = (_Float16)a; v[1] = (_Float16)b; return __builtin_bit_cast(unsigned, v); }
DI float hlo(unsigned u) { return (float)__builtin_bit_cast(f16x2_t, u)[0]; }
DI float hhi(unsigned u) { return (float)__builtin_bit_cast(f16x2_t, u)[1]; }
DI float bflo(unsigned u) { return __uint_as_float(u << 16); }
DI float bfhi(unsigned u) { return __uint_as_float(u & 0xffff0000u); }
DI float silu_f(float x) { return x / (1.f + __expf(-x)); }
DI int crow(int i, int h) { return (i & 3) + 8 * (i >> 2) + 4 * h; }
DI float shx(float v, int lane, int m) { return __int_as_float(__builtin_amdgcn_ds_bpermute((lane ^ m) << 2, __float_as_int(v))); }
DI float wave_sum(float v, int lane) {
#pragma unroll
    for (int o = 32; o >= 1; o >>= 1) v += shx(v, lane, o);
    return v;
}
#define MFMA32(a, b, c) __builtin_amdgcn_mfma_f32_32x32x16_bf16((a), (b), (c), 0, 0, 0)
template <int S> DI bf16x8 pack8(const f32x16& x) {
    u32x4 p; p[0] = pk2(x[8 * S], x[8 * S + 1]); p[1] = pk2(x[8 * S + 2], x[8 * S + 3]); p[2] = pk2(x[8 * S + 4], x[8 * S + 5]); p[3] = pk2(x[8 * S + 6], x[8 * S + 7]);
    return __builtin_bit_cast(bf16x8, p);
}
DI bf16x8 tr_pair(LAS unsigned char* lo_p, LAS unsigned char* hi_p) {
    s16x4 lo = __builtin_amdgcn_ds_read_tr16_b64_v4i16((LAS s16x4*)lo_p);
    s16x4 hi = __builtin_amdgcn_ds_read_tr16_b64_v4i16((LAS s16x4*)hi_p);
    return __builtin_shufflevector(lo, hi, 0, 1, 2, 3, 4, 5, 6, 7);
}
DI void lds_barrier() { asm volatile("s_waitcnt lgkmcnt(0)" ::: "memory"); __builtin_amdgcn_s_barrier(); asm volatile("" ::: "memory"); }
DI f32x16 zero16() { f32x16 z; for (int i = 0; i < 16; ++i) z[i] = 0.f; return z; }

namespace pg8 {
constexpr int BM = 256, BK = 64, HALF = 128, HTB = HALF * BK * 2, STAGE_BYTES = 8 * HTB, NXCD = 8, WGM = 8;
DI int lds_byte(int r, int c) { const int st = (r >> 4) * 2 + (c >> 5), rr = r & 15, cc = c & 31, ob = rr * 64 + cc * 2; return st * 1024 + (ob ^ (((ob >> 9) & 1) << 5)); }
DI void stage_rc(int b, int& R, int& C) { const int st = b / 1024, sb = b % 1024, swz = sb ^ (((sb >> 9) & 1) << 5); R = (st >> 1) * 16 + swz / 64; C = (st & 1) * 32 + (swz % 64) / 2; }
DI int perm32(int rho) { const int n = rho >> 4, i = rho & 15; return 8 * (i >> 2) + 4 * n + (i & 3); }
struct Unit { int pm, pn; };
struct Gemm { const bf16_t* A; const bf16_t* Bt; int M, N, K, lda, dil; };
DI size_t arow0(int pm, int dil) {
    const int m0 = pm * BM; if (dil == 1) return (size_t)m0;
    const int b = m0 >> 12, rem = m0 & 4095, n = 4096 / dil, r = rem / n, i0 = rem % n;
    return (size_t)(b * 4096 + i0 * dil + r);
}
struct StaticOrder {
    int nM, nN, nwg, G, c;
    DI void init(int M, int N, int G_, int c_) { nM = M / BM; nN = N / BM; nwg = nM * nN; G = G_; c = c_; }
    DI bool next(int i, Unit& u) const {
        const long L = (long)i * G + c; if (L >= nwg) return false;
        int wgid = (int)L; { const int q = nwg / NXCD, r = nwg % NXCD, xcd = wgid % NXCD, off = wgid / NXCD; wgid = (xcd < r ? xcd * (q + 1) : r * (q + 1) + (xcd - r) * q) + off; }
        const int nig = WGM * nN, gid = wgid / nig, fm = gid * WGM, gsz = (nM - fm) < WGM ? (nM - fm) : WGM;
        u.pm = fm + ((wgid % nig) % gsz); u.pn = (wgid % nig) / gsz; return true;
    }
};
struct EpiBf16 {
    static constexpr bool PERM = true, USES_SS = true;
    bf16_t* O; int ldc; int hm; const float* ss; int dil;
    DI void operator()(const f32x4 (&acc)[2][2][4][2], const Unit& u, int wr, int wc, int fr, int fq, const LAS float* rtab) const {
        asm volatile("" : "+v"(fr), "+v"(fq)); __builtin_assume(fr >= 0 && fr < 16 && fq >= 0 && fq < 4);
        const int row0 = u.pm * BM + wr * 64 + fr, col0 = u.pn * BM + wc * 32 + 8 * fq;
#pragma unroll
        for (int ai = 0; ai < 2; ++ai)
#pragma unroll
            for (int m = 0; m < 4; ++m) { const int row = row0 + ai * HALF + m * 16;
                float rs = 1.f;
                if (ss) rs = rtab ? rtab[wr * 64 + fr + ai * HALF + m * 16]
                                  : rsqrtf(((const GAS float*)ss)[arow0(u.pm, dil) + (size_t)(wr * 64 + fr + ai * HALF + m * 16) * dil] * (1.f / DM) + EPS);
#pragma unroll
                for (int bj = 0; bj < 2; ++bj) { const f32x4 v0 = acc[ai][bj][m][0] * rs, v1 = acc[ai][bj][m][1] * rs;
                    u32x4 w; w.x = pk2(v0[0], v0[1]); w.y = pk2(v0[2], v0[3]); w.z = pk2(v1[0], v1[1]); w.w = pk2(v1[2], v1[3]);
                    const int col = col0 + bj * HALF;
                    bf16_t* dst = hm ? O + ((size_t)(col >> 7) * T_TOK + row) * 128 + (col & 127) : O + (size_t)row * ldc + col;
                    *(GAS u32x4*)dst = w; } }
    }
};
struct EpiRes {
    static constexpr bool PERM = true, USES_SS = false;
    const float* xin; float* xout; const float* g1; bf16_t* h1; const float* g2; bf16_t* h2; float* ss;
    DI void operator()(const f32x4 (&acc)[2][2][4][2], const Unit& u, int wr, int wc, int fr, int fq, const LAS float* rtab) const {
        asm volatile("" : "+v"(fr), "+v"(fq)); __builtin_assume(fr >= 0 && fr < 16 && fq >= 0 && fq < 4);
        const int row0 = u.pm * BM + wr * 64 + fr, col0 = u.pn * BM + wc * 32 + 8 * fq;
        const float* g1p = h1 ? g1 : xin; const float* g2p = h2 ? g2 : xin;
        f32x4 ga[2][2], gb[2][2];
#pragma unroll
        for (int bj = 0; bj < 2; ++bj)
#pragma unroll
            for (int n = 0; n < 2; ++n) { ga[bj][n] = *(const GAS f32x4*)(g1p + col0 + bj * HALF + n * 4); gb[bj][n] = *(const GAS f32x4*)(g2p + col0 + bj * HALF + n * 4); }
#pragma unroll
        for (int ai = 0; ai < 2; ++ai)
#pragma unroll
            for (int mp = 0; mp < 2; ++mp) {
                f32x4 b[2][2][2];
#pragma unroll
                for (int mm = 0; mm < 2; ++mm) { const size_t off = (size_t)(row0 + ai * HALF + (2 * mp + mm) * 16) * DM + col0;
#pragma unroll
                    for (int bj = 0; bj < 2; ++bj)
#pragma unroll
                        for (int n = 0; n < 2; ++n) b[mm][bj][n] = *(const GAS f32x4*)(xin + off + bj * HALF + n * 4); }
#pragma unroll
                for (int mm = 0; mm < 2; ++mm) { const int m = 2 * mp + mm; const int row = row0 + ai * HALF + m * 16; const size_t off = (size_t)row * DM + col0;
                    float sq = 0.f;
#pragma unroll
                    for (int bj = 0; bj < 2; ++bj) {
#pragma unroll
                        for (int n = 0; n < 2; ++n) { const f32x4 v = b[mm][bj][n] + acc[ai][bj][m][n]; b[mm][bj][n] = v; *(GAS f32x4*)(xout + off + bj * HALF + n * 4) = v;
                            sq += (v.x * v.x + v.y * v.y) + (v.z * v.z + v.w * v.w); }
                        if (h1) { const f32x4 p0 = b[mm][bj][0] * ga[bj][0], p1 = b[mm][bj][1] * ga[bj][1];
                            u32x4 w; w.x = pk2(p0.x, p0.y); w.y = pk2(p0.z, p0.w); w.z = pk2(p1.x, p1.y); w.w = pk2(p1.z, p1.w); *(GAS u32x4*)(h1 + off + bj * HALF) = w; }
                        if (h2) { const f32x4 p0 = b[mm][bj][0] * gb[bj][0], p1 = b[mm][bj][1] * gb[bj][1];
                            u32x4 w; w.x = pk2(p0.x, p0.y); w.y = pk2(p0.z, p0.w); w.z = pk2(p1.x, p1.y); w.w = pk2(p1.z, p1.w); *(GAS u32x4*)(h2 + off + bj * HALF) = w; }
                    }
                    if (ss) { const int lane = fr | (fq << 4); sq += shx(sq, lane, 16); sq += shx(sq, lane, 32); if (fq == 0) atomicAdd(ss + row, sq); }
                }
            }
    }
};

template <class Epi>
DI void gemm_phase(LAS unsigned char* lds, const Gemm g, const StaticOrder& S, const Epi& E, int tid) {
    asm volatile("" : "+v"(tid)); __builtin_assume(tid >= 0 && tid < NT);
    const int wid = __builtin_amdgcn_readfirstlane(tid >> 6), lane = tid & 63, wr = wid >> 2, wc = wid & 3, fr = lane & 15, fq = lane >> 4;
    const int K = g.K, nt = K / BK;
    unsigned voffA[2], voffB[2];
#pragma unroll
    for (int i = 0; i < 2; ++i) { int R, C; stage_rc(tid * 16 + i * 8192, R, C); const int Rb = Epi::PERM ? ((R & ~31) + perm32(R & 31)) : R;
        voffA[i] = (unsigned)(R * g.dil * g.lda + C) * 2u; voffB[i] = (unsigned)(Rb * K + C) * 2u; }
    const size_t kstep = (size_t)(BK * 2);
    const size_t hstepA = (size_t)HALF * g.dil * g.lda * 2, hstepB = (size_t)HALF * K * 2, tstepB = 2 * hstepB;
    const unsigned ldsw = (unsigned)wid * 1024u;
    const int aoff = lds_byte(wr * 64 + fr, fq * 8), boff = lds_byte(wc * 32 + fr, fq * 8);
#define PG8_SA(b, h) (((b) * 2 + (h)) * HTB)
#define PG8_SB(b, h) ((4 + (b) * 2 + (h)) * HTB)
#define PG8_STAGE(bufoff, gbase, voff) do { _Pragma("unroll") for (int _i = 0; _i < 2; ++_i) \
        __builtin_amdgcn_global_load_lds((const unsigned*)((const char*)(gbase) + (voff)[_i]), (LAS unsigned*)(lds + (bufoff) + ldsw + _i * 8192), 16, 0, 0); } while (0)
#define PG8_LDA(dst, b, h) do { _Pragma("unroll") for (int m = 0; m < 4; ++m) _Pragma("unroll") for (int k = 0; k < 2; ++k) dst[m][k] = *(const LAS bf16x8*)(lds + PG8_SA(b, h) + aoff + m * 2048 + k * 1024); } while (0)
#define PG8_LDB(dst, b, h) do { _Pragma("unroll") for (int n = 0; n < 2; ++n) _Pragma("unroll") for (int k = 0; k < 2; ++k) dst[n][k] = *(const LAS bf16x8*)(lds + PG8_SB(b, h) + boff + n * 2048 + k * 1024); } while (0)
#define PG8_MMA(ai, bj, At, Bt) do { __builtin_amdgcn_s_setprio(1); _Pragma("unroll") for (int m = 0; m < 4; ++m) _Pragma("unroll") for (int n = 0; n < 2; ++n) _Pragma("unroll") for (int k = 0; k < 2; ++k) \
        acc[ai][bj][m][n] = __builtin_amdgcn_mfma_f32_16x16x32_bf16(Bt[n][k], At[m][k], acc[ai][bj][m][n], 0, 0, 0); __builtin_amdgcn_s_setprio(0); } while (0)
#define PG8_WAIT_V(n) asm volatile("s_waitcnt vmcnt(" #n ")" ::: "memory")
#define PG8_WAIT_L(n) asm volatile("s_waitcnt lgkmcnt(" #n ")" ::: "memory")
#define PG8_BAR __builtin_amdgcn_s_barrier()
#define PG8_SCHED __builtin_amdgcn_sched_barrier(0)
    Unit cur, nxt; int ui = 0;
    if (!S.next(0, cur)) return;
    LAS float* rtab_all = (LAS float*)(lds + STAGE_BYTES);
    if constexpr (Epi::USES_SS) {
        if (E.ss) {
            Unit tu;
#pragma unroll 1
            for (int i = 0; i < 8 && S.next(i, tu); ++i)
                if (tid < 256) rtab_all[i * 256 + tid] = rsqrtf(((const GAS float*)E.ss)[arow0(tu.pm, g.dil) + (size_t)tid * g.dil] * (1.f / DM) + EPS);
        }
        __syncthreads();
    }
    f32x4 acc[2][2][4][2];
#pragma unroll
    for (int a = 0; a < 2; ++a)
#pragma unroll
        for (int b = 0; b < 2; ++b)
#pragma unroll
            for (int m = 0; m < 4; ++m)
#pragma unroll
                for (int n = 0; n < 2; ++n) acc[a][b][m][n] = (f32x4){0.f, 0.f, 0.f, 0.f};
    bf16x8 At[4][2], B0[2][2], B1[2][2];
    const ptrdiff_t kend = (ptrdiff_t)(nt - 1) * (ptrdiff_t)kstep;
    ptrdiff_t kst = (ptrdiff_t)kstep;
    const char* cA = (const char*)g.A + arow0(cur.pm, g.dil) * (size_t)g.lda * 2; const char* cB = (const char*)g.Bt + (size_t)cur.pn * tstepB;
    PG8_STAGE(PG8_SB(0, 0), cB, voffB); PG8_STAGE(PG8_SB(0, 1), cB + hstepB, voffB); PG8_STAGE(PG8_SA(0, 0), cA, voffA); PG8_STAGE(PG8_SA(0, 1), cA + hstepA, voffA);
    if (wr == 1) PG8_BAR;
    PG8_WAIT_V(2); PG8_BAR;
    PG8_STAGE(PG8_SB(1, 0), cB + kst, voffB); PG8_STAGE(PG8_SA(1, 0), cA + kst, voffA); PG8_STAGE(PG8_SB(1, 1), cB + hstepB + kst, voffB);
    PG8_WAIT_V(6); PG8_BAR;
    for (;;) {
        const bool has_next = S.next(ui + 1, nxt);
        const bool nrev = has_next && ((ui + 1) & 1);
        const ptrdiff_t nkst = has_next ? (nrev ? -(ptrdiff_t)kstep : (ptrdiff_t)kstep) : kst;
        const char* nA = has_next ? (const char*)g.A + arow0(nxt.pm, g.dil) * (size_t)g.lda * 2 + (nrev ? kend : 0) : cA; const char* nB = has_next ? (const char*)g.Bt + (size_t)nxt.pn * tstepB + (nrev ? kend : 0) : cB;
        for (int t = 0; t < nt; t += 2) {
            const bool last = (t == nt - 2);
            const char* a1 = cA + (ptrdiff_t)(t + 1) * kst;
            const char* a2 = last ? nA : cA + (ptrdiff_t)(t + 2) * kst; const char* b2 = last ? nB : cB + (ptrdiff_t)(t + 2) * kst;
            const ptrdiff_t st3 = last ? nkst : kst; const char* a3 = a2 + st3; const char* b3 = b2 + st3;
            PG8_LDB(B0, 0, 0); PG8_LDB(B1, 0, 1); PG8_SCHED; PG8_LDA(At, 0, 0); PG8_STAGE(PG8_SA(1, 1), a1 + hstepA, voffA);
            PG8_WAIT_V(8); PG8_WAIT_L(0); PG8_BAR; PG8_MMA(0, 0, At, B0); PG8_MMA(0, 1, At, B1); PG8_BAR; PG8_SCHED;
            PG8_LDA(At, 0, 1); PG8_STAGE(PG8_SB(0, 0), b2, voffB); PG8_STAGE(PG8_SB(0, 1), b2 + hstepB, voffB); PG8_STAGE(PG8_SA(0, 0), a2, voffA);
            PG8_WAIT_V(8); PG8_WAIT_L(0); PG8_BAR; PG8_MMA(1, 0, At, B0); PG8_MMA(1, 1, At, B1); PG8_BAR; PG8_SCHED;
            PG8_LDB(B0, 1, 0); PG8_LDB(B1, 1, 1); PG8_SCHED; PG8_LDA(At, 1, 0); PG8_STAGE(PG8_SA(0, 1), a2 + hstepA, voffA);
            PG8_WAIT_V(8); PG8_WAIT_L(0); PG8_BAR; PG8_MMA(0, 0, At, B0); PG8_MMA(0, 1, At, B1); PG8_BAR; PG8_SCHED;
            PG8_LDA(At, 1, 1); PG8_STAGE(PG8_SB(1, 0), b3, voffB); PG8_STAGE(PG8_SB(1, 1), b3 + hstepB, voffB); PG8_STAGE(PG8_SA(1, 0), a3, voffA);
            PG8_WAIT_V(8); PG8_WAIT_L(0); PG8_BAR; PG8_MMA(1, 0, At, B0); PG8_MMA(1, 1, At, B1); PG8_BAR; PG8_SCHED;
        }
        if (wr == 0) PG8_BAR;
        E(acc, cur, wr, wc, fr, fq, ui < 8 ? rtab_all + ui * 256 : (LAS float*)nullptr);
        if (!has_next) break;
#pragma unroll
        for (int a = 0; a < 2; ++a)
#pragma unroll
            for (int b = 0; b < 2; ++b)
#pragma unroll
                for (int m = 0; m < 4; ++m)
#pragma unroll
                    for (int n = 0; n < 2; ++n) acc[a][b][m][n] = (f32x4){0.f, 0.f, 0.f, 0.f};
        cur = nxt; cA = nA; cB = nB; kst = nkst; ++ui;
        if (wr == 1) PG8_BAR;
    }
    PG8_WAIT_V(0);
    PG8_BAR;
#undef PG8_SA
#undef PG8_SB
#undef PG8_STAGE
#undef PG8_LDA
#undef PG8_LDB
#undef PG8_MMA
#undef PG8_WAIT_V
#undef PG8_WAIT_L
#undef PG8_BAR
#undef PG8_SCHED
}
}

template <int NCH, int CPR>
DI void load_rows(LAS unsigned char* dst, int dstride, const bf16_t* src, size_t ld, int zrows, int tid) {
    u32x4 v[NCH];
#pragma unroll
    for (int j = 0; j < NCH; ++j) { const int c = tid + NT * j, row = c / CPR, ch = c % CPR;
        v[j] = (u32x4){0u, 0u, 0u, 0u};
        if (row >= zrows) v[j] = *(const GAS u32x4*)(src + (ptrdiff_t)row * (ptrdiff_t)ld + ch * 8); }
#pragma unroll
    for (int j = 0; j < NCH; ++j) { const int c = tid + NT * j, row = c / CPR, ch = c % CPR;
        *(LAS u32x4*)(dst + row * dstride + ch * 16) = v[j]; }
}
template <int NCH, int CPR>
DI void ld_issue(u32x4 (&v)[NCH], const bf16_t* src, size_t ld, int zrows, int tid) {
#pragma unroll
    for (int j = 0; j < NCH; ++j) { const int c = tid + NT * j, row = c / CPR, ch = c % CPR;
        v[j] = (u32x4){0u, 0u, 0u, 0u};
        if (row >= zrows) v[j] = *(const GAS u32x4*)(src + (ptrdiff_t)row * (ptrdiff_t)ld + ch * 8); }
}
template <int NCH, int CPR>
DI void ld_commit(LAS unsigned char* dst, int dstride, const u32x4 (&v)[NCH], int tid) {
#pragma unroll
    for (int j = 0; j < NCH; ++j) { const int c = tid + NT * j, row = c / CPR, ch = c % CPR;
        *(LAS u32x4*)(dst + row * dstride + ch * 16) = v[j]; }
}
template <bool ZETA>
DI void load_rot(LAS unsigned char* dst, int dstride, const bf16_t* src, size_t ld, const float* cosT, const float* sinT, int pos0, float scale, float log2g, int tid) {
#pragma unroll
    for (int j = 0; j < 2; ++j) {
        const int c = tid + NT * j, row = c >> 3, ch = c & 7;
        const bf16_t* p = src + (size_t)row * ld + ch * 8;
        const u32x4 a = *(const GAS u32x4*)p, b = *(const GAS u32x4*)(p + 64);
        const unsigned* rp = (const unsigned*)cosT + (size_t)(pos0 + row) * 64 + ch * 8;
        const u32x4 r0 = *(const GAS u32x4*)rp, r1 = *(const GAS u32x4*)(rp + 4);
        float f = scale; if (ZETA) f *= exp2f((float)(127 - row) * log2g);
        u32x4 o1, o2;
#pragma unroll
        for (int k = 0; k < 4; ++k) {
            const float x1a = bflo(a[k]), x1b = bfhi(a[k]), x2a = bflo(b[k]), x2b = bfhi(b[k]);
            const unsigned ea = (k < 2) ? r0[2 * k] : r1[2 * k - 4], eb = (k < 2) ? r0[2 * k + 1] : r1[2 * k - 3];
            const float ca = hlo(ea), sa = hhi(ea), cb = hlo(eb), sb = hhi(eb);
            o1[k] = pk2((x1a * ca - x2a * sa) * f, (x1b * cb - x2b * sb) * f);
            o2[k] = pk2((x1a * sa + x2a * ca) * f, (x1b * sb + x2b * cb) * f);
        }
        *(LAS u32x4*)(dst + row * dstride + ch * 16) = o1;
        *(LAS u32x4*)(dst + row * dstride + 128 + ch * 16) = o2;
    }
}

DI void transpose_seg(const float* W, int K, int N, int nsrc0, int ncols, bf16_t* WT, int drow0, LAS float* scr, int gw, int ngw, int lane) {
    const int nblk = ncols / 64, nitems = (K / 64) * nblk;
    const int kk4 = lane >> 4, c4 = (lane & 15) * 4, c = lane & 7, n8 = lane >> 3;
    for (int item = gw; item < nitems; item += ngw) {
        const int kb = item / nblk, nb = item % nblk, k0 = 64 * kb, n0 = 64 * nb;
        const float* src = W + (size_t)(k0 + kk4) * N + nsrc0 + n0 + c4;
        f32x4 v[16];
#pragma unroll
        for (int i = 0; i < 16; ++i) v[i] = *(const GAS f32x4*)(src + (size_t)(4 * i) * N);
#pragma unroll
        for (int i = 0; i < 16; ++i) { LAS float* d = scr + (4 * i + kk4) * 65 + c4; d[0] = v[i].x; d[1] = v[i].y; d[2] = v[i].z; d[3] = v[i].w; }
        asm volatile("s_waitcnt lgkmcnt(0)" ::: "memory");
#pragma unroll
        for (int j = 0; j < 8; ++j) { const int n = n8 + 8 * j; const LAS float* s = scr + (8 * c) * 65 + n;
            u32x4 o; o.x = pk2(s[0 * 65], s[1 * 65]); o.y = pk2(s[2 * 65], s[3 * 65]); o.z = pk2(s[4 * 65], s[5 * 65]); o.w = pk2(s[6 * 65], s[7 * 65]);
            *(GAS u32x4*)(WT + (size_t)(drow0 + n0 + n) * K + k0 + 8 * c) = o; }
        asm volatile("s_waitcnt lgkmcnt(0)" ::: "memory");
    }
}
DI void norm_row_bf16(const float* xr, const float* g, bf16_t* o, int lane) {
    f32x4 v[8]; float s = 0.f;
#pragma unroll
    for (int j = 0; j < 8; ++j) { v[j] = ((const GAS f32x4*)xr)[lane + 64 * j]; s += (v[j].x * v[j].x + v[j].y * v[j].y) + (v[j].z * v[j].z + v[j].w * v[j].w); }
    const float rstd = rsqrtf(wave_sum(s, lane) * (1.f / DM) + EPS);
#pragma unroll
    for (int j = 0; j < 8; ++j) { const f32x4 gg = ((const GAS f32x4*)g)[lane + 64 * j];
        u32x2 w; w.x = pk2(v[j].x * rstd * gg.x, v[j].y * rstd * gg.y); w.y = pk2(v[j].z * rstd * gg.z, v[j].w * rstd * gg.w);
        ((GAS u32x2*)o)[lane + 64 * j] = w; }
}
DI void norm_rows(const float* x, const float* g, bf16_t* o, int nrows, int gw, int ngw, int lane) {
    for (int m = gw; m < nrows; m += ngw) norm_row_bf16(x + (size_t)m * DM, g, o + (size_t)m * DM, lane);
}

struct StRaw { u32x4 ka[2], kb[2], vv[2], r0[2], r1[2]; };
DI void st_issue(StRaw& r, const bf16_t* projA, const float* cosT, const float* sinT, int b, int hh, int es, int n, int tid) {
    const size_t row0 = (size_t)b * SEQ + n * 128;
#pragma unroll
    for (int j = 0; j < 2; ++j) {
        const int c = tid + NT * j, row = c >> 3, ch = c & 7;
        const bf16_t* p = projA + (row0 + row) * 8192 + 1024 + hh * 128 + ch * 8;
        r.ka[j] = *(const GAS u32x4*)p; r.kb[j] = *(const GAS u32x4*)(p + 64);
        const unsigned* rp = (const unsigned*)cosT + (size_t)(n * 128 + row) * 64 + ch * 8;
        r.r0[j] = *(const GAS u32x4*)rp; r.r1[j] = *(const GAS u32x4*)(rp + 4);
        r.vv[j] = *(const GAS u32x4*)(projA + (row0 + row) * 8192 + 2048 + hh * 256 + 64 * es + ch * 8);
    }
}
DI void st_commit(const StRaw& r, LAS unsigned char* Kz, LAS unsigned char* Vz, float log2g, int tid) {
#pragma unroll
    for (int j = 0; j < 2; ++j) {
        const int c = tid + NT * j, row = c >> 3, ch = c & 7;
        const float f = 0.08838834764831845f * exp2f((float)(127 - row) * log2g);
        const u32x4 a = r.ka[j], b = r.kb[j], r0 = r.r0[j], r1 = r.r1[j];
        u32x4 o1, o2;
#pragma unroll
        for (int k = 0; k < 4; ++k) {
            const float x1a = bflo(a[k]), x1b = bfhi(a[k]), x2a = bflo(b[k]), x2b = bfhi(b[k]);
            const unsigned ea = (k < 2) ? r0[2 * k] : r1[2 * k - 4], eb = (k < 2) ? r0[2 * k + 1] : r1[2 * k - 3];
            const float ca = hlo(ea), sa = hhi(ea), cb = hlo(eb), sb = hhi(eb);
            o1[k] = pk2((x1a * ca - x2a * sa) * f, (x1b * cb - x2b * sb) * f);
            o2[k] = pk2((x1a * sa + x2a * ca) * f, (x1b * sb + x2b * cb) * f);
        }
        *(LAS u32x4*)(Kz + row * 320 + ch * 16) = o1;
        *(LAS u32x4*)(Kz + row * 320 + 128 + ch * 16) = o2;
        *(LAS u32x4*)(Vz + row * 192 + ch * 16) = r.vv[j];
    }
}
DI void ret_state_item(LAS unsigned char* lds, const bf16_t* projA, bf16_t* rprev, const float* cosT, const float* sinT, int item, int tid) {
    asm volatile("" : "+v"(tid)); __builtin_assume(tid >= 0 && tid < NT);
    const int lane = tid & 63, w = __builtin_amdgcn_readfirstlane(tid >> 6), h = lane >> 5, blk = (lane >> 4) & 1, q4 = (lane & 15) >> 2, p4 = lane & 3;
    const int es = item & 3, hh = (item >> 2) & 7, b = item >> 5;
    const int et = w & 1, dt = w >> 1;
    const float log2g = log2f(1.f - exp2f(-5.f - (float)hh));
    const float gchunk = exp2f(128.f * log2g);
    f32x16 acc = zero16();
    StRaw raw;
    st_issue(raw, projA, cosT, sinT, b, hh, es, 0, tid);
#pragma unroll 1
    for (int n = 0; n < 32; ++n) {
        bf16_t* rp = rprev + ((size_t)((b * 8 + hh) * 32 + n) * 256 + 64 * es + 32 * et) * 128 + 32 * dt + (lane & 31);
#pragma unroll
        for (int i = 0; i < 16; ++i) ((GAS bf16_t*)rp)[(size_t)crow(i, h) * 128] = (bf16_t)(pk2(acc[i], 0.f) & 0xffffu);
        if (n == 31) break;
        LAS unsigned char* Kz = lds + (n & 1) * 65536;
        LAS unsigned char* Vz = Kz + 128 * 320;
        st_commit(raw, Kz, Vz, log2g, tid);
        if (n < 30) st_issue(raw, projA, cosT, sinT, b, hh, es, n + 1, tid);
        lds_barrier();
#pragma unroll
        for (int i = 0; i < 16; ++i) acc[i] *= gchunk;
#pragma unroll
        for (int ks = 0; ks < 8; ++ks) {
            const int r0 = 16 * ks + 8 * h + q4;
            const bf16x8 a = tr_pair(Vz + r0 * 192 + (32 * et + 16 * blk + 4 * p4) * 2, Vz + (r0 + 4) * 192 + (32 * et + 16 * blk + 4 * p4) * 2);
            const bf16x8 bb = tr_pair(Kz + r0 * 320 + (32 * dt + 16 * blk + 4 * p4) * 2, Kz + (r0 + 4) * 320 + (32 * dt + 16 * blk + 4 * p4) * 2);
            acc = MFMA32(a, bb, acc);
        }
    }
    lds_barrier();
}

DI void ret_out_item(LAS unsigned char* lds, const bf16_t* projA, const bf16_t* rprev, bf16_t* mix, const float* cosT, const float* sinT, int item, int tid) {
    asm volatile("" : "+v"(tid)); __builtin_assume(tid >= 0 && tid < NT);
    const int lane = tid & 63, w = __builtin_amdgcn_readfirstlane(tid >> 6), h = lane >> 5, blk = (lane >> 4) & 1, q4 = (lane & 15) >> 2, p4 = lane & 3, ql = lane & 31;
    const int n = item & 31, hh = (item >> 5) & 7, b = item >> 8;
    const int qsub = w & 3, eh = w >> 2;
    const float log2g = log2f(1.f - exp2f(-5.f - (float)hh));
    LAS unsigned char* Qs = lds;
    LAS unsigned char* Ks = lds + 34816;
    LAS unsigned char* Rs = lds + 69632;
    LAS unsigned char* Vs = lds;
    LAS float* red = (LAS float*)(lds + 139264);
    const size_t row0 = (size_t)b * SEQ + n * 128;
    lds_barrier();
    load_rot<false>(Qs, 272, projA + row0 * 8192 + hh * 128, 8192, cosT, sinT, n * 128, 1.f, 0.f, tid);
    load_rot<false>(Ks, 272, projA + row0 * 8192 + 1024 + hh * 128, 8192, cosT, sinT, n * 128, 0.08838834764831845f, 0.f, tid);
    load_rows<8, 16>(Rs, 272, rprev + (size_t)((b * 8 + hh) * 32 + n) * 256 * 128, 128, 0, tid);
    lds_barrier();
    u32x4 vreg[8];
    ld_issue<8, 32>(vreg, projA + row0 * 8192 + 2048 + hh * 256, 8192, 0, tid);
    __builtin_amdgcn_sched_barrier(0);
    bf16x8 qf[8];
#pragma unroll
    for (int ks = 0; ks < 8; ++ks) qf[ks] = *(const LAS bf16x8*)(Qs + (32 * qsub + ql) * 272 + (16 * ks + 8 * h) * 2);
    bf16x8 pf[4][2];
#pragma unroll
    for (int kt = 0; kt < 4; ++kt) {
        if (kt <= qsub) {
            f32x16 s = zero16();
#pragma unroll
            for (int ks = 0; ks < 8; ++ks) { const bf16x8 a = *(const LAS bf16x8*)(Ks + (32 * kt + ql) * 272 + (16 * ks + 8 * h) * 2); s = MFMA32(a, qf[ks], s); }
#pragma unroll
            for (int i = 0; i < 16; ++i) { const int dq = (32 * qsub + ql) - (32 * kt + crow(i, h)); s[i] = (dq >= 0) ? s[i] * __builtin_amdgcn_exp2f((float)dq * log2g) : 0.f; }
            pf[kt][0] = pack8<0>(s); pf[kt][1] = pack8<1>(s);
            __builtin_amdgcn_sched_barrier(0);
        } else { pf[kt][0] = (bf16x8){0, 0, 0, 0, 0, 0, 0, 0}; pf[kt][1] = pf[kt][0]; }
    }
    f32x16 o[4];
    const float xi = exp2f((float)(32 * qsub + ql + 1) * log2g);
#pragma unroll
    for (int et = 0; et < 4; ++et) {
        o[et] = zero16();
#pragma unroll
        for (int ks = 0; ks < 8; ++ks) { const bf16x8 a = *(const LAS bf16x8*)(Rs + (128 * eh + 32 * et + ql) * 272 + (16 * ks + 8 * h) * 2); o[et] = MFMA32(a, qf[ks], o[et]); }
#pragma unroll
        for (int i = 0; i < 16; ++i) o[et][i] *= xi;
    }
    lds_barrier();
    ld_commit<8, 32>(Vs, 576, vreg, tid);
    lds_barrier();
#pragma unroll
    for (int et = 0; et < 4; ++et)
#pragma unroll
        for (int kt = 0; kt < 4; ++kt)
            if (kt <= qsub) {
#pragma unroll
                for (int s = 0; s < 2; ++s) {
                    const int r0 = 32 * kt + 16 * s + 4 * h + q4; const int cb = (128 * eh + 32 * et + 16 * blk + 4 * p4) * 2;
                    const bf16x8 a = tr_pair(Vs + r0 * 576 + cb, Vs + (r0 + 8) * 576 + cb);
                    o[et] = MFMA32(a, pf[kt][s], o[et]);
                }
            }
    float ss = 0.f;
#pragma unroll
    for (int et = 0; et < 4; ++et)
#pragma unroll
        for (int i = 0; i < 16; ++i) ss += o[et][i] * o[et][i];
    ss += shx(ss, lane, 32);
    if (h == 0) red[eh * 128 + 32 * qsub + ql] = ss;
    lds_barrier();
    const float tot = red[32 * qsub + ql] + red[128 + 32 * qsub + ql];
    const float rstd = rsqrtf(tot * (1.f / 256.f) + EPS);
    const size_t tok = row0 + 32 * qsub + ql;
    const bf16_t* gp = projA + tok * 8192 + 4096 + hh * 256 + 128 * eh + 4 * h;
    bf16_t* op = mix + tok * 3072 + hh * 256 + 128 * eh + 4 * h;
    u32x2 gvv[4][4];
#pragma unroll
    for (int et = 0; et < 4; ++et)
#pragma unroll
        for (int i4 = 0; i4 < 4; ++i4) gvv[et][i4] = *(const GAS u32x2*)(gp + 32 * et + 8 * i4);
#pragma unroll
    for (int et = 0; et < 4; ++et)
#pragma unroll
        for (int i4 = 0; i4 < 4; ++i4) {
            const u32x2 gv = gvv[et][i4];
            u32x2 wv;
            wv.x = pk2(o[et][4 * i4] * rstd * silu_f(bflo(gv.x)), o[et][4 * i4 + 1] * rstd * silu_f(bfhi(gv.x)));
            wv.y = pk2(o[et][4 * i4 + 2] * rstd * silu_f(bflo(gv.y)), o[et][4 * i4 + 3] * rstd * silu_f(bfhi(gv.y)));
            *(GAS u32x2*)(op + 32 * et + 8 * i4) = wv;
        }
}

DI void mem_attn_item(LAS unsigned char* lds, const bf16_t* qp, size_t ldq, const bf16_t* gatep, size_t ldg, bf16_t* outp, size_t ldo,
                      const bf16_t* kmem, const bf16_t* vmem, int tid, int eh_sel = -1) {
    asm volatile("" : "+v"(tid)); __builtin_assume(tid >= 0 && tid < NT);
    const int lane = tid & 63, w = __builtin_amdgcn_readfirstlane(tid >> 6), h = lane >> 5, blk = (lane >> 4) & 1, q4 = (lane & 15) >> 2, p4 = lane & 3, ql = lane & 31;
    LAS unsigned char* Ks = lds;
    LAS unsigned char* Vs = lds;
    lds_barrier();
    load_rows<16, 32>(Ks, 528, kmem, 8192, 0, tid);
    lds_barrier();
    const int eh_lo = (eh_sel < 0) ? 0 : eh_sel, eh_hi = (eh_sel < 0) ? 2 : eh_sel + 1;
    u32x4 vreg[8];
    ld_issue<8, 16>(vreg, vmem + 128 * eh_lo, 8192, 0, tid);
    __builtin_amdgcn_sched_barrier(0);
    const bf16_t* qrow = qp + (size_t)(32 * w + ql) * ldq + 8 * h;
    f32x16 s[8];
#pragma unroll
    for (int kt = 0; kt < 8; ++kt) s[kt] = zero16();
#pragma unroll
    for (int dh = 0; dh < 2; ++dh) {
        bf16x8 qf[8];
#pragma unroll
        for (int ks = 0; ks < 8; ++ks) qf[ks] = *(const GAS bf16x8*)(qrow + 128 * dh + 16 * ks);
#pragma unroll
        for (int kt = 0; kt < 8; ++kt)
#pragma unroll
            for (int ks = 0; ks < 8; ++ks) { const bf16x8 a = *(const LAS bf16x8*)(Ks + (32 * kt + ql) * 528 + (128 * dh + 16 * ks + 8 * h) * 2); s[kt] = MFMA32(a, qf[ks], s[kt]); }
    }
    const float c = 0.0625f * LOG2E;
    float m = -3.0e38f;
#pragma unroll
    for (int kt = 0; kt < 8; ++kt)
#pragma unroll
        for (int i = 0; i < 16; ++i) { s[kt][i] *= c; m = fmaxf(m, s[kt][i]); }
    m = fmaxf(m, shx(m, lane, 32));
    float l = 0.f;
    bf16x8 pf[8][2];
#pragma unroll
    for (int kt = 0; kt < 8; ++kt) {
#pragma unroll
        for (int i = 0; i < 16; ++i) { s[kt][i] = __builtin_amdgcn_exp2f(s[kt][i] - m); l += s[kt][i]; }
        pf[kt][0] = pack8<0>(s[kt]); pf[kt][1] = pack8<1>(s[kt]);
        __builtin_amdgcn_sched_barrier(0);
    }
    l += shx(l, lane, 32);
    const float rl = 1.f / l;
#pragma unroll 1
    for (int eh = eh_lo; eh < eh_hi; ++eh) {
        lds_barrier();
        ld_commit<8, 16>(Vs, 320, vreg, tid);
        if (eh + 1 < eh_hi) ld_issue<8, 16>(vreg, vmem + 128 * (eh + 1), 8192, 0, tid);
        lds_barrier();
        f32x16 o[4];
#pragma unroll
        for (int et = 0; et < 4; ++et) {
            o[et] = zero16();
#pragma unroll
            for (int kt = 0; kt < 8; ++kt)
#pragma unroll
                for (int sx = 0; sx < 2; ++sx) {
                    const int r0 = 32 * kt + 16 * sx + 4 * h + q4; const int cb = (32 * et + 16 * blk + 4 * p4) * 2;
                    const bf16x8 a = tr_pair(Vs + r0 * 320 + cb, Vs + (r0 + 8) * 320 + cb);
                    o[et] = MFMA32(a, pf[kt][sx], o[et]);
                }
        }
        const bf16_t* gp = gatep + (size_t)(32 * w + ql) * ldg + 128 * eh + 4 * h;
        bf16_t* op = outp + (size_t)(32 * w + ql) * ldo + 128 * eh + 4 * h;
        u32x2 gvv[4][4];
#pragma unroll
        for (int et = 0; et < 4; ++et)
#pragma unroll
            for (int i4 = 0; i4 < 4; ++i4) gvv[et][i4] = *(const GAS u32x2*)(gp + 32 * et + 8 * i4);
#pragma unroll
        for (int et = 0; et < 4; ++et)
#pragma unroll
            for (int i4 = 0; i4 < 4; ++i4) {
                const u32x2 gv = gvv[et][i4];
                u32x2 wv;
                wv.x = pk2(o[et][4 * i4] * rl * silu_f(bflo(gv.x)), o[et][4 * i4 + 1] * rl * silu_f(bfhi(gv.x)));
                wv.y = pk2(o[et][4 * i4 + 2] * rl * silu_f(bflo(gv.y)), o[et][4 * i4 + 3] * rl * silu_f(bfhi(gv.y)));
                *(GAS u32x2*)(op + 32 * et + 8 * i4) = wv;
            }
    }
}

DI void dil_attn_item(LAS unsigned char* lds, bf16_t* qp, size_t ldq, const bf16_t* kp, const bf16_t* vp, float* lsep  , int i0, int tid, bool dry = false) {
    asm volatile("" : "+v"(tid)); __builtin_assume(tid >= 0 && tid < NT);
    const int lane = tid & 63, w = __builtin_amdgcn_readfirstlane(tid >> 6), h = lane >> 5, blk = (lane >> 4) & 1, q4 = (lane & 15) >> 2, p4 = lane & 3, ql = lane & 31;
    LAS unsigned char* Ks = lds;
    LAS unsigned char* Vs = lds;
    const int zr = (i0 == 0) ? 128 : 0;
    __syncthreads();
    load_rows<12, 16>(Ks, 272, kp - (ptrdiff_t)128 * 128, 128, zr, tid);
    bf16x8 qf[8];
    bf16_t* qrow = qp + (size_t)(32 * w + ql) * ldq;
#pragma unroll
    for (int ks = 0; ks < 8; ++ks) qf[ks] = *(const GAS bf16x8*)(qrow + 16 * ks + 8 * h);
    __syncthreads();
    u32x4 vreg[12];
    ld_issue<12, 16>(vreg, vp - (ptrdiff_t)128 * 128, 128, zr, tid);
    __builtin_amdgcn_sched_barrier(0);
    f32x16 s[5];
#pragma unroll
    for (int kt = 0; kt < 5; ++kt) {
        s[kt] = zero16();
#pragma unroll
        for (int ks = 0; ks < 8; ++ks) { const bf16x8 a = *(const LAS bf16x8*)(Ks + (32 * w + 32 * kt + ql) * 272 + (16 * ks + 8 * h) * 2); s[kt] = MFMA32(a, qf[ks], s[kt]); }
    }
    const float c = 0.08838834764831845f * LOG2E;
    float m = -3.0e38f;
#pragma unroll
    for (int kt = 0; kt < 5; ++kt)
#pragma unroll
        for (int i = 0; i < 16; ++i) {
            const int kr = crow(i, h);
            bool valid = true;
            if (kt == 0) valid = (kr >= ql);
            if (kt == 4) valid = (kr <= ql);
            if (zr) valid = valid && (32 * w + 32 * kt + kr >= 128);
            s[kt][i] = valid ? s[kt][i] * c : -3.0e38f;
            m = fmaxf(m, s[kt][i]);
        }
    m = fmaxf(m, shx(m, lane, 32));
    float l = 0.f;
    bf16x8 pf[5][2];
#pragma unroll
    for (int kt = 0; kt < 5; ++kt) {
#pragma unroll
        for (int i = 0; i < 16; ++i) { s[kt][i] = __builtin_amdgcn_exp2f(s[kt][i] - m); l += s[kt][i]; }
        pf[kt][0] = pack8<0>(s[kt]); pf[kt][1] = pack8<1>(s[kt]);
        __builtin_amdgcn_sched_barrier(0);
    }
    l += shx(l, lane, 32);
    const float rl = 1.f / l;
    __syncthreads();
    ld_commit<12, 16>(Vs, 320, vreg, tid);
    __syncthreads();
    f32x16 o[4];
#pragma unroll
    for (int dt = 0; dt < 4; ++dt) {
        o[dt] = zero16();
#pragma unroll
        for (int kt = 0; kt < 5; ++kt)
#pragma unroll
            for (int sx = 0; sx < 2; ++sx) {
                const int r0 = 32 * w + 32 * kt + 16 * sx + 4 * h + q4; const int cb = (32 * dt + 16 * blk + 4 * p4) * 2;
                const bf16x8 a = tr_pair(Vs + r0 * 320 + cb, Vs + (r0 + 8) * 320 + cb);
                o[dt] = MFMA32(a, pf[kt][sx], o[dt]);
            }
    }
#pragma unroll
    for (int dt = 0; dt < 4; ++dt)
#pragma unroll
        for (int i4 = 0; i4 < 4; ++i4) {
            u32x2 wv; wv.x = pk2(o[dt][4 * i4] * rl, o[dt][4 * i4 + 1] * rl); wv.y = pk2(o[dt][4 * i4 + 2] * rl, o[dt][4 * i4 + 3] * rl);
            if (!dry) *(GAS u32x2*)(qrow + 32 * dt + 8 * i4 + 4 * h) = wv;
        }
    if (h == 0 && !dry) lsep[(size_t)(32 * w + ql) * 16] = m * LN2 + __logf(l);
}

struct DilItem { bf16_t* qp; const bf16_t* kp; const bf16_t* vp; float* lsep; int zr; };
DI DilItem dil_decode(unsigned char* ws, int hb, int it) {
    const int head = it & 15, blkr = (it >> 4) & 31, gi = it >> 9;
    const int n = (gi == 0) ? 4096 : (gi == 1 ? 1024 : 256);
    const int colq = (gi == 0) ? 0 : (gi == 1 ? 6144 : 8192);
    const int ml0 = blkr * 256, i0 = (ml0 & 4095) % n; const size_t mg0 = (size_t)hb * 8192 + ml0;
    const bf16_t* kvg = (bf16_t*)(ws + WS_KV) + (size_t)gi * T_TOK * 4096;
    DilItem d;
    d.qp = (bf16_t*)(ws + WS_P) + (size_t)ml0 * 10240 + colq + head * 128;
    d.kp = kvg + ((size_t)head * T_TOK + mg0) * 128 - (ptrdiff_t)128 * 128;
    d.vp = kvg + ((size_t)(16 + head) * T_TOK + mg0) * 128 - (ptrdiff_t)128 * 128;
    d.lsep = (float*)(ws + WS_LSE) + ((size_t)gi * 8192 + ml0) * 16 + head;
    d.zr = (i0 == 0) ? 128 : 0;
    return d;
}
DI void dil_attn_phase(LAS unsigned char* lds, unsigned char* ws, int hb, int it_begin, int it_end, bool merge, int bid, int G, int tid) {
    asm volatile("" : "+v"(tid)); __builtin_assume(tid >= 0 && tid < NT);
    const int lane = tid & 63, w = __builtin_amdgcn_readfirstlane(tid >> 6), h = lane >> 5, blk = (lane >> 4) & 1, q4 = (lane & 15) >> 2, p4 = lane & 3, ql = lane & 31;
    LAS unsigned char* Ks = lds;
    LAS unsigned char* Vs = lds;
    if (it_begin + bid >= it_end) return;
    DilItem cur = dil_decode(ws, hb, it_begin + bid);
    u32x4 kvreg[12];
    bf16x8 qf[8];
    ld_issue<12, 16>(kvreg, cur.kp, 128, cur.zr, tid);
#pragma unroll 1
    for (int it = it_begin + bid; it < it_end; it += G) {
        const bool has_next = (it + G) < it_end;
        DilItem nxt = cur; if (has_next) nxt = dil_decode(ws, hb, it + G);
        bf16_t* orow = cur.qp + (size_t)(32 * w + ql) * 10240;
#pragma unroll
        for (int ks = 0; ks < 8; ++ks) qf[ks] = *(const GAS bf16x8*)(orow + 16 * ks + 8 * h);
        lds_barrier();
        ld_commit<12, 16>(Ks, 272, kvreg, tid);
        ld_issue<12, 16>(kvreg, cur.vp, 128, cur.zr, tid);
        lds_barrier();
        f32x16 s[5];
#pragma unroll
        for (int kt = 0; kt < 5; ++kt) {
            s[kt] = zero16();
#pragma unroll
            for (int ks = 0; ks < 8; ++ks) { const bf16x8 a = *(const LAS bf16x8*)(Ks + (32 * w + 32 * kt + ql) * 272 + (16 * ks + 8 * h) * 2); s[kt] = MFMA32(a, qf[ks], s[kt]); }
        }
        const float c = 0.08838834764831845f * LOG2E;
        float m = -3.0e38f;
#pragma unroll
        for (int kt = 0; kt < 5; ++kt)
#pragma unroll
            for (int i = 0; i < 16; ++i) {
                const int kr = crow(i, h);
                bool valid = true;
                if (kt == 0) valid = (kr >= ql);
                if (kt == 4) valid = (kr <= ql);
                if (cur.zr) valid = valid && (32 * w + 32 * kt + kr >= 128);
                s[kt][i] = valid ? s[kt][i] * c : -3.0e38f;
                m = fmaxf(m, s[kt][i]);
            }
        m = fmaxf(m, shx(m, lane, 32));
        float l = 0.f;
        bf16x8 pf[5][2];
#pragma unroll
        for (int kt = 0; kt < 5; ++kt) {
#pragma unroll
            for (int i = 0; i < 16; ++i) { s[kt][i] = __builtin_amdgcn_exp2f(s[kt][i] - m); l += s[kt][i]; }
            pf[kt][0] = pack8<0>(s[kt]); pf[kt][1] = pack8<1>(s[kt]);
            __builtin_amdgcn_sched_barrier(0);
        }
        l += shx(l, lane, 32);
        const float rl = 1.f / l;
        lds_barrier();
        ld_commit<12, 16>(Vs, 320, kvreg, tid);
        lds_barrier();
        f32x16 o[4];
#pragma unroll
        for (int dt = 0; dt < 4; ++dt) {
            o[dt] = zero16();
#pragma unroll
            for (int kt = 0; kt < 5; ++kt)
#pragma unroll
                for (int sx = 0; sx < 2; ++sx) {
                    const int r0 = 32 * w + 32 * kt + 16 * sx + 4 * h + q4; const int cb = (32 * dt + 16 * blk + 4 * p4) * 2;
                    const bf16x8 a = tr_pair(Vs + r0 * 320 + cb, Vs + (r0 + 8) * 320 + cb);
                    o[dt] = MFMA32(a, pf[kt][sx], o[dt]);
                }
        }
        __builtin_amdgcn_sched_barrier(0);
        if (has_next) ld_issue<12, 16>(kvreg, nxt.kp, 128, nxt.zr, tid);
        lds_barrier();
        LAS unsigned char* stg = lds + w * (32 * 272);
#pragma unroll
        for (int dt = 0; dt < 4; ++dt)
#pragma unroll
            for (int i4 = 0; i4 < 4; ++i4) {
                u32x2 wv; wv.x = pk2(o[dt][4 * i4] * rl, o[dt][4 * i4 + 1] * rl); wv.y = pk2(o[dt][4 * i4 + 2] * rl, o[dt][4 * i4 + 3] * rl);
                *(LAS u32x2*)(stg + ql * 272 + (32 * dt + 8 * i4 + 4 * h) * 2) = wv;
            }
        const float lse_q = m * LN2 + __logf(l);
        LAS float* stgl = (LAS float*)(lds + 8 * (32 * 272)) + w * 32;
        if (!merge) { if (h == 0) ((GAS float*)cur.lsep)[(size_t)(32 * w + ql) * 16] = lse_q; }
        else if (h == 0) stgl[ql] = lse_q;
        if (!merge) {
            bf16_t* ob = cur.qp + (size_t)(32 * w) * 10240;
            bf16_t* op = ob + (size_t)(lane >> 4) * 10240 + (lane & 15) * 8; LAS unsigned char* sp = stg + (lane >> 4) * 272 + (lane & 15) * 16;
#pragma unroll 2
            for (int j = 0; j < 8; ++j) { *(GAS u32x4*)op = *(const LAS u32x4*)sp; op += 4 * 10240; sp += 4 * 272; }
        } else {
            bf16_t* pB = (bf16_t*)(ws + WS_P); const float* lse = (const float*)(ws + WS_LSE);
            const int hd = (int)((cur.qp - pB) % 10240) >> 7;
            const int ml0 = (int)((cur.qp - pB) / 10240);
#pragma unroll 1
            for (int jb = 0; jb < 8; jb += 4) {
                u32x4 v1a[4], v2a[4], gva[4]; float l1a[4], l2a[4];
#pragma unroll
                for (int jj = 0; jj < 4; ++jj) {
                    const int r = (lane >> 4) + 4 * (jb + jj), c8 = (lane & 15) * 8;
                    const int tl = ml0 + 32 * w + r, b = tl >> 12, ti = tl & 4095;
                    const int m1 = b * 4096 + (ti & 3) * 1024 + (ti >> 2), m2 = b * 4096 + (ti & 15) * 256 + (ti >> 4);
                    l1a[jj] = ((const GAS float*)lse)[((size_t)8192 + m1) * 16 + hd]; l2a[jj] = ((const GAS float*)lse)[((size_t)16384 + m2) * 16 + hd];
                    v1a[jj] = *(const GAS u32x4*)(pB + (size_t)m1 * 10240 + 6144 + hd * 128 + c8); v2a[jj] = *(const GAS u32x4*)(pB + (size_t)m2 * 10240 + 8192 + hd * 128 + c8);
                    gva[jj] = *(const GAS u32x4*)(pB + (size_t)tl * 10240 + hd * 128 + c8 + 4096);
                }
#pragma unroll
                for (int jj = 0; jj < 4; ++jj) {
                    const int r = (lane >> 4) + 4 * (jb + jj), c8 = (lane & 15) * 8;
                    const int tl = ml0 + 32 * w + r;
                    const float l0 = stgl[r], l1 = l1a[jj], l2 = l2a[jj];
                    const u32x4 v0 = *(const LAS u32x4*)(stg + r * 272 + (lane & 15) * 16);
                    const u32x4 v1 = v1a[jj], v2 = v2a[jj], gv = gva[jj];
                    bf16_t* orow0 = pB + (size_t)tl * 10240 + hd * 128 + c8;
                    const float mx = fmaxf(l0, fmaxf(l1, l2));
                    float a0 = __expf(l0 - mx), a1 = __expf(l1 - mx), a2 = __expf(l2 - mx); const float rs = 1.f / (a0 + a1 + a2); a0 *= rs; a1 *= rs; a2 *= rs;
                    u32x4 ov;
#pragma unroll
                    for (int k = 0; k < 4; ++k) {
                        const float ea = a0 * bflo(v0[k]) + a1 * bflo(v1[k]) + a2 * bflo(v2[k]), eb = a0 * bfhi(v0[k]) + a1 * bfhi(v1[k]) + a2 * bfhi(v2[k]);
                        ov[k] = pk2(ea * silu_f(bflo(gv[k])), eb * silu_f(bfhi(gv[k])));
                    }
                    *(GAS u32x4*)orow0 = ov;
                }
            }
        }
        cur = nxt;
    }
    lds_barrier();
}

#define XB_TMO      128
#define XB_XCNT(j)  (256  + 64 * (j))
#define XB_XSUB(j)  (1280 + 64 * (j))
#define XB_XGEN(j)  (2304 + 64 * (j))
#define XB_TOP      3328
#define XB_TOPGEN   3392
#define XCD_BAR_WORDS 3456
#define XB_SPIN_CAP (1u << 18)

__device__ __forceinline__ unsigned xb_ld(unsigned* p)              { return __hip_atomic_load(p, __ATOMIC_RELAXED, __HIP_MEMORY_SCOPE_AGENT); }
__device__ __forceinline__ unsigned xb_add(unsigned* p, unsigned v) { return __hip_atomic_fetch_add(p, v, __ATOMIC_RELAXED, __HIP_MEMORY_SCOPE_AGENT); }
__device__ __forceinline__ unsigned xb_xcc_id() { return (unsigned)__builtin_amdgcn_s_getreg((3 << 11) | 20) & 0xFu; }
#define XB_SPIN(cond, bar) do { unsigned _sp = 0; while (cond) { __builtin_amdgcn_s_sleep(1); \
    if ((++_sp & 255u) == 0u) { if (xb_ld(&(bar)[XB_TMO])) break; if (_sp > XB_SPIN_CAP) { atomicAdd(&(bar)[XB_TMO], 1u); break; } } } } while (0)

struct XcdBarrier {
    unsigned* bar; unsigned x;
    volatile LAS unsigned* st;
};

__device__ __forceinline__ XcdBarrier xcd_barrier_post(unsigned* bar, volatile LAS unsigned* st) {
    XcdBarrier b; b.bar = bar; b.x = xb_xcc_id(); b.st = st;
    if (threadIdx.x == 0) (void)xb_add(&bar[XB_XCNT(b.x)], 1u);
    return b;
}
__device__ __forceinline__ void xcd_barrier_complete(unsigned* bar, unsigned x, unsigned& nloc, unsigned& nx) {
    const unsigned G = gridDim.x * gridDim.y * gridDim.z;
    unsigned sum, cnt, mine, sp = 0u;
    for (;;) {
        sum = 0u; cnt = 0u; mine = 0u;
#pragma unroll
        for (unsigned j = 0; j < 16; ++j) { const unsigned c = xb_ld(&bar[XB_XCNT(j)]); sum += c; cnt += (c > 0u) ? 1u : 0u; mine = (j == x) ? c : mine; }
        if (sum == G) break;
        __builtin_amdgcn_s_sleep(1);
        if ((++sp & 255u) == 0u) { if (xb_ld(&bar[XB_TMO])) break; if (sp > XB_SPIN_CAP) { atomicAdd(&bar[XB_TMO], 1u); break; } }
    }
    nloc = mine > 0u ? mine : 1u; nx = cnt > 0u ? cnt : 1u;
}

__device__ __forceinline__ void xcd_barrier(const XcdBarrier& b, bool leader) {
    asm volatile("s_waitcnt vmcnt(0)" ::: "memory");
    __syncthreads();
    if (leader) {
        unsigned* bar = b.bar;
        __builtin_amdgcn_s_waitcnt(0);
        unsigned nloc = b.st[0], nx = b.st[1];
        if (nloc == 0u) { xcd_barrier_complete(bar, b.x, nloc, nx); b.st[0] = nloc; b.st[1] = nx; }
        const unsigned old = xb_add(&bar[XB_XSUB(b.x)], 1u);
        const unsigned gen = old / nloc;
        if (old + 1u == (gen + 1u) * nloc) {
            __builtin_amdgcn_fence(__ATOMIC_RELEASE, "agent");
            asm volatile("s_waitcnt vmcnt(0)" ::: "memory");
            const unsigned og = xb_add(&bar[XB_TOP], 1u);
            const unsigned tg = og / nx;
            if (og + 1u == (tg + 1u) * nx) xb_add(&bar[XB_TOPGEN], 1u);
            else XB_SPIN(xb_ld(&bar[XB_TOPGEN]) == tg, bar);
            __builtin_amdgcn_fence(__ATOMIC_ACQUIRE, "agent");
            xb_add(&bar[XB_XGEN(b.x)], 1u);
            asm volatile("s_waitcnt vmcnt(0)" ::: "memory");
        } else {
            XB_SPIN(xb_ld(&bar[XB_XGEN(b.x)]) == gen, bar);
            __builtin_amdgcn_fence(__ATOMIC_ACQUIRE, "agent");
            asm volatile("s_waitcnt vmcnt(0)" ::: "memory");
        }
    }
    __syncthreads();
}


struct Params {
    const float *x, *mem, *norm_a, *w_in_a, *w_out_a, *norm_b, *w_in_b, *w_out_b, *w_mem_kv, *mem_norm_g, *kv_norm_g, *w_kv, *final_norm_g;
    float* out; unsigned char* ws; int ph_lo, ph_hi;
};
enum { K_PRO = 0, K_A_GEMM, K_A_STATE, K_A_RETOUT, K_A_OUT, K_KV, K_B_GEMM, K_B_ATTN, K_B_OUT, K_FINAL };
enum { T_NONE = 0, T_PRO, T_A0_STATE, T_A1_STATE, T_A1_OUT, T_KV, T_B0H1_ATTN, T_B1H0_GEMM };

struct TrJob { const float* W; int K, N, nsrc0, ncols; bf16_t* WT; int drow0; };
DI bool tr_job(const Params& p, unsigned char* ws, int tag, int j, TrJob& t) {
    bf16_t* Win = (bf16_t*)(ws + WS_WIN); bf16_t* Wout = (bf16_t*)(ws + WS_WOUT);
    if (tag == T_PRO) {
        if (j == 0) { t = TrJob{p.w_in_a, 2048, 8192, 0, 8192, Win, 0}; return true; }
        if (j == 1) { t = TrJob{p.w_out_a, 3072, 2048, 0, 2048, Wout, 0}; return true; }
        if (j < 6) { t = TrJob{p.w_mem_kv + (size_t)(j - 2) * 2048 * 2048, 2048, 2048, 0, 2048, (bf16_t*)(ws + WS_WMEMT), (j - 2) * 2048}; return true; }
        return false;
    }
    if (tag == T_A0_STATE) { if (j == 0) { t = TrJob{p.w_in_a + (size_t)2048 * 8192, 2048, 8192, 0, 8192, Win, 0}; return true; } return false; }
    if (tag == T_A1_OUT) { if (j == 0) { t = TrJob{p.w_kv, 2048, 12288, 0, 12288, (bf16_t*)(ws + WS_WKVT), 0}; return true; } return false; }
    if (tag == T_KV) { if (j == 0) { t = TrJob{p.w_out_b, 3072, 2048, 0, 2048, Wout, 0}; return true; } return false; }
    if (tag == T_B1H0_GEMM) { if (j == 0) { t = TrJob{p.w_out_b + (size_t)3072 * 2048, 3072, 2048, 0, 2048, Wout, 0}; return true; } return false; }
    if (tag == T_A1_STATE || tag == T_B0H1_ATTN) {
        const float* wi = p.w_in_b + (tag == T_A1_STATE ? 0 : (size_t)2048 * 10240);
        switch (j) {
            case 0: t = TrJob{wi, 2048, 10240, 0, 2048, Win, 0}; return true;
            case 1: t = TrJob{wi, 2048, 10240, 8192, 1024, Win, 3072}; return true;
            case 2: t = TrJob{wi, 2048, 10240, 9216, 1024, Win, 2048}; return true;
            case 3: t = TrJob{wi, 2048, 10240, 6144, 2048, Win, 4096}; return true;
            case 4: t = TrJob{wi, 2048, 10240, 2048, 2048, Win, 6144}; return true;
            case 5: t = TrJob{wi, 2048, 10240, 4096, 2048, Win, 8192}; return true;
            case 6: if (tag == T_A1_STATE) { t = TrJob{p.w_out_a + (size_t)3072 * 2048, 3072, 2048, 0, 2048, Wout, 0}; return true; } return false;
            default: return false;
        }
    }
    return false;
}
DI bool gemm_job(const Params& p, unsigned char* ws, int kind, int la, int lb, int hb, int j, int G, int bid, pg8::Gemm& g, pg8::EpiBf16& E, int& c) {
    c = bid;
    bf16_t* Win = (bf16_t*)(ws + WS_WIN); const float* SS = (const float*)(ws + WS_SS);
    if (kind == K_A_GEMM) {
        if (j == 0) { g = pg8::Gemm{(bf16_t*)(ws + WS_HA), Win, T_TOK, 8192, 2048, 2048, 1}; E = pg8::EpiBf16{(bf16_t*)(ws + WS_PROJA), 8192, 0, la == 0 ? nullptr : SS, 1}; return true; }
        if (j == 1 && la == 0) { g = pg8::Gemm{(bf16_t*)(ws + WS_MEMN), (bf16_t*)(ws + WS_WMEMT), 1024, 8192, 2048, 2048, 1}; E = pg8::EpiBf16{(bf16_t*)(ws + WS_MEMKV), 8192, 0, nullptr, 1}; c = (bid + G / 2) % G; return true; }
        return false;
    }
    if (kind == K_KV) {
        if (j >= 3) return false;
        const int dil = (j == 0) ? 1 : (j == 1 ? 4 : 16);
        g = pg8::Gemm{(bf16_t*)(ws + WS_HA), (bf16_t*)(ws + WS_WKVT) + (size_t)j * 4096 * 2048, T_TOK, 4096, 2048, 2048, dil};
        E = pg8::EpiBf16{(bf16_t*)(ws + WS_KV) + (size_t)j * T_TOK * 4096, 4096, 1, SS + T_TOK, dil}; return true;
    }
    if (kind == K_B_GEMM) {
        bf16_t* hB = (bf16_t*)(ws + WS_HB) + (size_t)hb * 8192 * DM; bf16_t* projB = (bf16_t*)(ws + WS_P);
        const float* ssb = SS + (size_t)(1 + lb) * T_TOK + (size_t)hb * 8192;
        if (j == 0) { g = pg8::Gemm{hB, Win, 8192, 6144, 2048, 2048, 1}; E = pg8::EpiBf16{projB, 10240, 0, ssb, 1}; return true; }
        if (j == 1) { g = pg8::Gemm{hB, Win + (size_t)6144 * 2048, 8192, 2048, 2048, 2048, 4}; E = pg8::EpiBf16{projB + 6144, 10240, 0, ssb, 4}; return true; }
        if (j == 2) { g = pg8::Gemm{hB, Win + (size_t)8192 * 2048, 8192, 2048, 2048, 2048, 16}; E = pg8::EpiBf16{projB + 8192, 10240, 0, ssb, 16}; return true; }
        return false;
    }
    return false;
}

__global__ void __launch_bounds__(NT, 2) yoco_fwd(Params p) {
    extern __shared__ __attribute__((aligned(16))) unsigned char lds_raw[];
    LAS unsigned char* lds = (LAS unsigned char*)lds_raw;
    const int bid = blockIdx.x;
    const int wave0 = __builtin_amdgcn_readfirstlane(threadIdx.x >> 6);
    volatile LAS unsigned* bst = (volatile LAS unsigned*)(lds + LDS_BYTES - 16);
    if (threadIdx.x < 2) bst[threadIdx.x] = 0u;
    __syncthreads();
    (void)xcd_barrier_post((unsigned*)(p.ws + WS_BAR), bst);
    unsigned long long t_prev = PROBE_TGROUP ? __builtin_amdgcn_s_memrealtime() : 0ull, t_acc = 0ull;
#pragma unroll 1
    for (int ph = p.ph_lo; ph < p.ph_hi; ++ph) {
        unsigned zz = 0u; asm volatile("" : "+s"(zz));
#define TIDX() const int tid = (wave0 << 6) | (int)__builtin_amdgcn_mbcnt_hi(~0u, __builtin_amdgcn_mbcnt_lo(~0u, zz)); __builtin_assume(tid >= 0 && tid < NT); const int lane = tid & 63, wave = wave0; const int gw = bid * 8 + wave; (void)lane; (void)wave; (void)gw
        int G = gridDim.x; asm volatile("" : "+s"(G));
        const int ngw = G * 8;
        unsigned char* ws_raw = p.ws; asm volatile("" : "+s"(ws_raw));
        unsigned char* ws = (unsigned char*)(__attribute__((address_space(1))) unsigned char*)ws_raw;
        int kind, la = 0, lb = 0, hb = 0;
        if (ph == 0) kind = K_PRO;
        else if (ph <= 8) { la = (ph - 1) / 4; kind = K_A_GEMM + (ph - 1) % 4; }
        else if (ph == 9) kind = K_KV;
        else if (ph <= 21) { const int idx = ph - 10; lb = idx / 6; hb = (idx / 3) % 2; kind = K_B_GEMM + idx % 3; }
        else kind = K_FINAL;
        int ttag = T_NONE, tngw = ngw; bool t_first = false;
        if (kind == K_PRO) { ttag = T_PRO; t_first = true; }
        else if (kind == K_A_RETOUT && la == 1) ttag = T_A1_STATE;
        else if (kind == K_A_OUT) ttag = (la == 0) ? T_A0_STATE : T_A1_OUT;
        else if (kind == K_KV) ttag = T_KV;
        else if (kind == K_B_ATTN && lb == 0 && hb == 1) ttag = T_B0H1_ATTN;
        else if (kind == K_B_GEMM && lb == 1 && hb == 0) ttag = T_B1H0_GEMM;

        if (kind == K_PRO) {
            TIDX();
            norm_rows(p.mem, p.mem_norm_g, (bf16_t*)(ws + WS_MEMN), 1024, gw, ngw, lane);
            float* cosT = (float*)(ws + WS_COS); float* sinT = (float*)(ws + WS_SIN); float* SSw = (float*)(ws + WS_SS);
            for (int i = bid * NT + tid; i < 4096 * 64; i += G * NT) { const int pos = i >> 6, j = i & 63;
                const float inv = 1.0f / powf(10000.0f, (float)j * (1.0f / 63.0f)); const float ang = (float)pos * inv;
                ((GAS unsigned*)cosT)[i] = pkh2(cosf(ang), sinf(ang)); }
            for (int i = bid * NT + tid; i < 3 * T_TOK; i += G * NT) ((GAS float*)SSw)[i] = 0.f;
            norm_rows(p.x, p.norm_a, (bf16_t*)(ws + WS_HA), T_TOK, gw, ngw, lane);
        }
        if (kind == K_A_GEMM || kind == K_KV || kind == K_B_GEMM) {
            TIDX();
            pg8::Gemm g; pg8::EpiBf16 E; int c;
#pragma unroll 1
            for (int j = 0; gemm_job(p, ws, kind, la, lb, hb, j, G, bid, g, E, c); ++j) { pg8::StaticOrder S; S.init(g.M, g.N, G, c); pg8::gemm_phase(lds, g, S, E, tid); }
        }
        const bool t_early = (kind == K_A_OUT) && (bid & 1) && (ttag != T_NONE);
        if (t_early) {
            TIDX(); const int tgw = gw;
            LAS float* scr = (LAS float*)(lds + wave * 16640);
            TrJob t;
#pragma unroll 1
            for (int j = 0; tr_job(p, ws, ttag, j, t); ++j) transpose_seg(t.W, t.K, t.N, t.nsrc0, t.ncols, t.WT, t.drow0, scr, tgw, tngw, lane);
            __syncthreads();
        }
        if (kind == K_A_OUT || kind == K_B_OUT) {
            TIDX();
            pg8::Gemm g; pg8::EpiRes E; float* SSw = (float*)(ws + WS_SS);
            if (kind == K_A_OUT) {
                g = pg8::Gemm{(bf16_t*)(ws + WS_MIXA), (bf16_t*)(ws + WS_WOUT), T_TOK, 2048, 3072, 3072, 1};
                if (la == 0) E = pg8::EpiRes{p.x, p.out, p.norm_a + 2048, (bf16_t*)(ws + WS_HA), nullptr, nullptr, SSw};
                else E = pg8::EpiRes{p.out, p.out, p.kv_norm_g, (bf16_t*)(ws + WS_HA), p.norm_b, (bf16_t*)(ws + WS_HB), SSw + T_TOK};
            } else {
                float* xh = p.out + (size_t)hb * 8192 * DM;
                g = pg8::Gemm{(bf16_t*)(ws + WS_P), (bf16_t*)(ws + WS_WOUT), 8192, 2048, 3072, 10240, 1};
                if (lb == 0) E = pg8::EpiRes{xh, xh, p.norm_b + 2048, (bf16_t*)(ws + WS_HB) + (size_t)hb * 8192 * DM, nullptr, nullptr, SSw + 2 * T_TOK + (size_t)hb * 8192};
                else E = pg8::EpiRes{xh, xh, nullptr, nullptr, nullptr, nullptr, nullptr};
            }
            pg8::StaticOrder S; S.init(g.M, g.N, G, bid); pg8::gemm_phase(lds, g, S, E, tid);
        }
        if (kind == K_A_STATE) {
            TIDX();
#pragma unroll 1
            for (int it = bid; it < 128; it += G) { __syncthreads(); ret_state_item(lds, (bf16_t*)(ws + WS_PROJA), (bf16_t*)(ws + WS_RPREV), (float*)(ws + WS_COS), (float*)(ws + WS_SIN), it, tid); }
        }
        if (kind == K_B_ATTN) { TIDX(); dil_attn_phase(lds, ws, hb, 512, 1536, false, bid, G, tid); }
        if (kind == K_A_STATE || kind == K_B_ATTN) {
            TIDX();
            const bool isA = (kind == K_A_STATE);
            const int nit = 256;
            const int first = (isA && G >= 256) ? 128 : 0;
            const bf16_t* memKV = (bf16_t*)(ws + WS_MEMKV);
            if (bid >= first) {
#pragma unroll 1
                for (int it0 = bid - first; it0 < nit; it0 += G - first) {
                    const int it = isA ? it0 : (it0 >> 1); const int ehs = isA ? -1 : (it0 & 1);
                    const int mh = it & 3, blkr = it >> 2; const size_t row0 = (size_t)blkr * 256;
                    const int b = isA ? (blkr >> 4) : (hb * 2 + (blkr >> 4)); const int layer = isA ? la : 2 + lb;
                    const bf16_t* km = memKV + (size_t)b * 256 * 8192 + layer * 2048 + mh * 256;
                    const bf16_t* qp; const bf16_t* gp; bf16_t* op; size_t ldq, ldo;
                    if (isA) { const bf16_t* pa = (bf16_t*)(ws + WS_PROJA) + row0 * 8192; qp = pa + 6144 + mh * 256; gp = pa + 7168 + mh * 256; ldq = 8192; op = (bf16_t*)(ws + WS_MIXA) + row0 * 3072 + 2048 + mh * 256; ldo = 3072; }
                    else { bf16_t* pb = (bf16_t*)(ws + WS_P) + row0 * 10240; qp = pb + 3072 + mh * 256; gp = pb + 2048 + mh * 256; ldq = 10240; op = pb + 2048 + mh * 256; ldo = 10240; }
                    mem_attn_item(lds, qp, ldq, gp, ldq, op, ldo, km, km + 1024, tid, ehs);
                }
            }
        }
        if (kind == K_A_RETOUT) {
            TIDX();
#pragma unroll 1
            for (int it = bid; it < 1024; it += G) ret_out_item(lds, (bf16_t*)(ws + WS_PROJA), (bf16_t*)(ws + WS_RPREV), (bf16_t*)(ws + WS_MIXA), (float*)(ws + WS_COS), (float*)(ws + WS_SIN), it, tid);
        }
        if (kind == K_B_ATTN) {
            TIDX();
            { XcdBarrier xb; xb.bar = (unsigned*)(ws + WS_BAR); xb.x = xb_xcc_id(); xb.st = (volatile LAS unsigned*)(lds + LDS_BYTES - 16); xcd_barrier(xb, tid == 0); }
            dil_attn_phase(lds, ws, hb, 0, 512, true, bid, G, tid);
        }
        if (kind == K_FINAL) {
            TIDX();
#pragma unroll 1
            for (int m = gw; m < T_TOK; m += ngw) {
                float* xr = p.out + (size_t)m * DM;
                f32x4 v[8]; float s = 0.f;
#pragma unroll
                for (int j = 0; j < 8; ++j) { v[j] = ((const GAS f32x4*)xr)[lane + 64 * j]; s += (v[j].x * v[j].x + v[j].y * v[j].y) + (v[j].z * v[j].z + v[j].w * v[j].w); }
                const float rstd = rsqrtf(wave_sum(s, lane) * (1.f / DM) + EPS);
#pragma unroll
                for (int j = 0; j < 8; ++j) { const f32x4 gg = ((const GAS f32x4*)p.final_norm_g)[lane + 64 * j]; ((GAS f32x4*)xr)[lane + 64 * j] = v[j] * rstd * gg; }
            }
        }
        if (ttag != T_NONE && !t_early) {
            TIDX(); const int tgw = gw;
            __syncthreads();
            LAS float* scr = (LAS float*)(lds + wave * 16640);
            TrJob t;
#pragma unroll 1
            for (int j = 0; tr_job(p, ws, ttag, j, t); ++j) transpose_seg(t.W, t.K, t.N, t.nsrc0, t.ncols, t.WT, t.drow0, scr, tgw, tngw, lane);
        }
        if (ph + 1 < p.ph_hi) {
            if (ph == p.ph_lo) cg::this_grid().sync();
            else { TIDX(); XcdBarrier xb; xb.bar = (unsigned*)(ws + WS_BAR); xb.x = xb_xcc_id(); xb.st = (volatile LAS unsigned*)(lds + LDS_BYTES - 16); xcd_barrier(xb, tid == 0); }
        }
        if (PROBE_TGROUP) { const unsigned long long t_now = __builtin_amdgcn_s_memrealtime(); if ((PROBE_TGROUP >> kind) & 1) t_acc += t_now - t_prev; t_prev = t_now; }
    }
    if (PROBE_TGROUP && blockIdx.x == 0) { const unsigned long long t0 = __builtin_amdgcn_s_memrealtime(); while (__builtin_amdgcn_s_memrealtime() - t0 < 4ull * t_acc) __builtin_amdgcn_s_sleep(8); }
}

constexpr int N_PHASES = 1 + 2 * 4 + 1 + 4 * 3 + 1;

extern "C" void kernel_launch(void* const* d_in, const int* in_sizes, int n_in, void* d_out, int out_size, void* d_ws, size_t ws_size, hipStream_t stream) {
    static int grid = 0;
    if (grid == 0) {
        if (ws_size < WS_END) { fprintf(stderr, "kernel_launch: workspace too small: %zu < %zu\n", ws_size, (size_t)WS_END); grid = -1; return; }
        int dev = 0, cus = 0, per_cu = 0;
        hipGetDevice(&dev);
        hipDeviceGetAttribute(&cus, hipDeviceAttributeMultiprocessorCount, dev);
        if (hipFuncSetAttribute((const void*)yoco_fwd, hipFuncAttributeMaxDynamicSharedMemorySize, LDS_BYTES) != hipSuccess) { fprintf(stderr, "kernel_launch: hipFuncSetAttribute failed\n"); grid = -1; return; }
        if (hipOccupancyMaxActiveBlocksPerMultiprocessor(&per_cu, (const void*)yoco_fwd, NT, LDS_BYTES) != hipSuccess || per_cu < 1) { fprintf(stderr, "kernel_launch: occupancy query gave %d\n", per_cu); per_cu = 1; }
        (void)hipGetLastError();
        grid = cus;
        fprintf(stderr, "kernel_launch: grid %d (cus %d, per_cu %d), ws %zu\n", grid, cus, per_cu, ws_size);
    }
    if (grid < 0) return;
    (void)hipMemsetAsync((char*)d_ws + WS_BAR, 0, 16384, stream);
    Params p{};
    p.x = (const float*)d_in[0]; p.mem = (const float*)d_in[1]; p.norm_a = (const float*)d_in[2]; p.w_in_a = (const float*)d_in[3]; p.w_out_a = (const float*)d_in[4];
    p.norm_b = (const float*)d_in[5]; p.w_in_b = (const float*)d_in[6]; p.w_out_b = (const float*)d_in[7]; p.w_mem_kv = (const float*)d_in[8]; p.mem_norm_g = (const float*)d_in[9];
    p.kv_norm_g = (const float*)d_in[10]; p.w_kv = (const float*)d_in[11]; p.final_norm_g = (const float*)d_in[12];
    p.out = (float*)d_out; p.ws = (unsigned char*)d_ws;
#if MK_SPLIT
    for (int k = 0; k < N_PHASES; ++k) {
        p.ph_lo = k; p.ph_hi = k + 1;
        hipLaunchKernelGGL(yoco_fwd, dim3(grid), dim3(NT), LDS_BYTES, stream, p);
    }
#else
    p.ph_lo = 0; p.ph_hi = N_PHASES;
    void* args[] = {&p};
    hipError_t e = hipLaunchCooperativeKernel((const void*)yoco_fwd, dim3(grid), dim3(NT), args, LDS_BYTES, stream);
    if (e != hipSuccess) fprintf(stderr, "cooperative launch failed: %s (grid %d)\n", hipGetErrorString(e), grid);
#endif
}
```

```cpp
#include <hip/hip_runtime.h>
#include <hip/hip_cooperative_groups.h>
#include <cstdio>
#include <cstdint>
namespace cg = cooperative_groups;

#ifndef MK_SPLIT
#define MK_SPLIT 0
#endif

#ifndef PROBE_TGROUP
#define PROBE_TGROUP 0
#endif
#ifndef PROBE_GEMM
#define PROBE_GEMM 0
#endif
#ifndef PROBE_RET
#define PROBE_RET 0
#endif
#ifndef PROBE_ATTN
#define PROBE_ATTN 0
#endif
#define LAS __attribute__((address_space(3)))
#define GAS __attribute__((address_space(1)))
#define DI __device__ __forceinline__
typedef unsigned short bf16_t;
typedef short bf16x8 __attribute__((ext_vector_type(8)));
typedef short s16x4 __attribute__((ext_vector_type(4)));
typedef float f32x4 __attribute__((ext_vector_type(4)));
typedef float f32x16 __attribute__((ext_vector_type(16)));
typedef unsigned u32x4 __attribute__((ext_vector_type(4)));
typedef unsigned u32x2 __attribute__((ext_vector_type(2)));
typedef __bf16 nbf16x2 __attribute__((ext_vector_type(2)));

constexpr int NT = 512;
constexpr int T_TOK = 16384, DM = 2048, SEQ = 4096;
constexpr int LDS_BYTES = 144 * 1024;
constexpr float EPS = 1e-6f;
constexpr float LOG2E = 1.4426950408889634f, LN2 = 0.6931471805599453f;

constexpr size_t MiB = 1048576;
constexpr size_t WS_KV   = 0;
constexpr size_t WS_PROJA = 0;
constexpr size_t WS_MIXA = 256 * MiB;
constexpr size_t WS_WMEMT = 352 * MiB;
constexpr size_t WS_P    = 384 * MiB;
constexpr size_t WS_HA   = 384 * MiB;
constexpr size_t WS_RPREV = 448 * MiB;
constexpr size_t WS_WKVT = 448 * MiB;
constexpr size_t WS_MEMN = 512 * MiB;
constexpr size_t WS_HB   = 544 * MiB;
constexpr size_t WS_WIN  = 608 * MiB;
constexpr size_t WS_WOUT = 648 * MiB;
constexpr size_t WS_MEMKV = 660 * MiB;
constexpr size_t WS_COS  = 676 * MiB;
constexpr size_t WS_SIN  = 677 * MiB;
constexpr size_t WS_LSE  = 678 * MiB;
constexpr size_t WS_BAR  = 679 * MiB + 512 * 1024;
constexpr size_t WS_SS   = 679 * MiB + 512 * 1024 + 65536;
constexpr size_t WS_END  = 680 * MiB;

DI unsigned pk2(float a, float b) { nbf16x2 v; v[0] = (__bf16)a; v[1] = (__bf16)b; return __builtin_bit_cast(unsigned, v); }
DI float bflo(unsigned u) { return __uint_as_float(u << 16); }
DI float bfhi(unsigned u) { return __uint_as_float(u & 0xffff0000u); }
DI float silu_f(float x) { return x / (1.f + __expf(-x)); }
DI int crow(int i, int h) { return (i & 3) + 8 * (i >> 2) + 4 * h; }
DI float shx(float v, int lane, int m) { return __int_as_float(__builtin_amdgcn_ds_bpermute((lane ^ m) << 2, __float_as_int(v))); }
DI float wave_sum(float v, int lane) {
#pragma unroll
    for (int o = 32; o >= 1; o >>= 1) v += shx(v, lane, o);
    return v;
}
#define MFMA32(a, b, c) __builtin_amdgcn_mfma_f32_32x32x16_bf16((a), (b), (c), 0, 0, 0)
template <int S> DI bf16x8 pack8(const f32x16& x) {
    u32x4 p; p[0] = pk2(x[8 * S], x[8 * S + 1]); p[1] = pk2(x[8 * S + 2], x[8 * S + 3]); p[2] = pk2(x[8 * S + 4], x[8 * S + 5]); p[3] = pk2(x[8 * S + 6], x[8 * S + 7]);
    return __builtin_bit_cast(bf16x8, p);
}
DI bf16x8 tr_pair(LAS unsigned char* lo_p, LAS unsigned char* hi_p) {
    s16x4 lo = __builtin_amdgcn_ds_read_tr16_b64_v4i16((LAS s16x4*)lo_p);
    s16x4 hi = __builtin_amdgcn_ds_read_tr16_b64_v4i16((LAS s16x4*)hi_p);
    return __builtin_shufflevector(lo, hi, 0, 1, 2, 3, 4, 5, 6, 7);
}
DI void lds_barrier() { asm volatile("s_waitcnt lgkmcnt(0)" ::: "memory"); __builtin_amdgcn_s_barrier(); asm volatile("" ::: "memory"); }
DI f32x16 zero16() { f32x16 z; for (int i = 0; i < 16; ++i) z[i] = 0.f; return z; }

namespace pg8 {
constexpr int BM = 256, BK = 64, HALF = 128, HTB = HALF * BK * 2, STAGE_BYTES = 8 * HTB, NXCD = 8, WGM = 8;
DI int lds_byte(int r, int c) { const int st = (r >> 4) * 2 + (c >> 5), rr = r & 15, cc = c & 31, ob = rr * 64 + cc * 2; return st * 1024 + (ob ^ (((ob >> 9) & 1) << 5)); }
DI void stage_rc(int b, int& R, int& C) { const int st = b / 1024, sb = b % 1024, swz = sb ^ (((sb >> 9) & 1) << 5); R = (st >> 1) * 16 + swz / 64; C = (st & 1) * 32 + (swz % 64) / 2; }
DI int perm32(int rho) { const int n = rho >> 4, i = rho & 15; return 8 * (i >> 2) + 4 * n + (i & 3); }
struct Unit { int pm, pn; };
struct Gemm { const bf16_t* A; const bf16_t* Bt; int M, N, K, lda, dil; };
DI size_t arow0(int pm, int dil) {
    const int m0 = pm * BM; if (dil == 1) return (size_t)m0;
    const int b = m0 >> 12, rem = m0 & 4095, n = 4096 / dil, r = rem / n, i0 = rem % n;
    return (size_t)(b * 4096 + i0 * dil + r);
}
struct StaticOrder {
    int nM, nN, nwg, G, c;
    DI void init(int M, int N, int G_, int c_) { nM = M / BM; nN = N / BM; nwg = nM * nN; G = G_; c = c_; }
    DI bool next(int i, Unit& u) const {
        const long L = (long)i * G + c; if (L >= nwg) return false;
        int wgid = (int)L; { const int q = nwg / NXCD, r = nwg % NXCD, xcd = wgid % NXCD, off = wgid / NXCD; wgid = (xcd < r ? xcd * (q + 1) : r * (q + 1) + (xcd - r) * q) + off; }
        const int nig = WGM * nN, gid = wgid / nig, fm = gid * WGM, gsz = (nM - fm) < WGM ? (nM - fm) : WGM;
        u.pm = fm + ((wgid % nig) % gsz); u.pn = (wgid % nig) / gsz; return true;
    }
};
struct EpiBf16 {
    static constexpr bool PERM = true, USES_SS = true;
    bf16_t* O; int ldc; int hm; const float* ss; int dil;
    DI void operator()(const f32x4 (&acc)[2][2][4][2], const Unit& u, int wr, int wc, int fr, int fq, const LAS float* rtab) const {
        asm volatile("" : "+v"(fr), "+v"(fq)); __builtin_assume(fr >= 0 && fr < 16 && fq >= 0 && fq < 4);
        const int row0 = u.pm * BM + wr * 64 + fr, col0 = u.pn * BM + wc * 32 + 8 * fq;
#pragma unroll
        for (int ai = 0; ai < 2; ++ai)
#pragma unroll
            for (int m = 0; m < 4; ++m) { const int row = row0 + ai * HALF + m * 16;
                float rs = 1.f;
                if (ss) rs = rtab ? rtab[wr * 64 + fr + ai * HALF + m * 16]
                                  : rsqrtf(((const GAS float*)ss)[arow0(u.pm, dil) + (size_t)(wr * 64 + fr + ai * HALF + m * 16) * dil] * (1.f / DM) + EPS);
#pragma unroll
                for (int bj = 0; bj < 2; ++bj) { const f32x4 v0 = acc[ai][bj][m][0] * rs, v1 = acc[ai][bj][m][1] * rs;
                    u32x4 w; w.x = pk2(v0[0], v0[1]); w.y = pk2(v0[2], v0[3]); w.z = pk2(v1[0], v1[1]); w.w = pk2(v1[2], v1[3]);
                    const int col = col0 + bj * HALF;
                    bf16_t* dst = hm ? O + ((size_t)(col >> 7) * T_TOK + row) * 128 + (col & 127) : O + (size_t)row * ldc + col;
                    *(GAS u32x4*)dst = w; } }
    }
};
struct EpiRes {
    static constexpr bool PERM = true, USES_SS = false;
    const float* xin; float* xout; const float* g1; bf16_t* h1; const float* g2; bf16_t* h2; float* ss;
    DI void operator()(const f32x4 (&acc)[2][2][4][2], const Unit& u, int wr, int wc, int fr, int fq, const LAS float* rtab) const {
        asm volatile("" : "+v"(fr), "+v"(fq)); __builtin_assume(fr >= 0 && fr < 16 && fq >= 0 && fq < 4);
        const int row0 = u.pm * BM + wr * 64 + fr, col0 = u.pn * BM + wc * 32 + 8 * fq;
        const float* g1p = h1 ? g1 : xin; const float* g2p = h2 ? g2 : xin;
        f32x4 ga[2][2], gb[2][2];
#pragma unroll
        for (int bj = 0; bj < 2; ++bj)
#pragma unroll
            for (int n = 0; n < 2; ++n) { ga[bj][n] = *(const GAS f32x4*)(g1p + col0 + bj * HALF + n * 4); gb[bj][n] = *(const GAS f32x4*)(g2p + col0 + bj * HALF + n * 4); }
#pragma unroll
        for (int ai = 0; ai < 2; ++ai)
#pragma unroll
            for (int mp = 0; mp < 2; ++mp) {
                f32x4 b[2][2][2];
#pragma unroll
                for (int mm = 0; mm < 2; ++mm) { const size_t off = (size_t)(row0 + ai * HALF + (2 * mp + mm) * 16) * DM + col0;
#pragma unroll
                    for (int bj = 0; bj < 2; ++bj)
#pragma unroll
                        for (int n = 0; n < 2; ++n) b[mm][bj][n] = *(const GAS f32x4*)(xin + off + bj * HALF + n * 4); }
#pragma unroll
                for (int mm = 0; mm < 2; ++mm) { const int m = 2 * mp + mm; const int row = row0 + ai * HALF + m * 16; const size_t off = (size_t)row * DM + col0;
                    float sq = 0.f;
#pragma unroll
                    for (int bj = 0; bj < 2; ++bj) {
#pragma unroll
                        for (int n = 0; n < 2; ++n) { const f32x4 v = b[mm][bj][n] + acc[ai][bj][m][n]; b[mm][bj][n] = v; *(GAS f32x4*)(xout + off + bj * HALF + n * 4) = v;
                            sq += (v.x * v.x + v.y * v.y) + (v.z * v.z + v.w * v.w); }
                        if (h1) { const f32x4 p0 = b[mm][bj][0] * ga[bj][0], p1 = b[mm][bj][1] * ga[bj][1];
                            u32x4 w; w.x = pk2(p0.x, p0.y); w.y = pk2(p0.z, p0.w); w.z = pk2(p1.x, p1.y); w.w = pk2(p1.z, p1.w); *(GAS u32x4*)(h1 + off + bj * HALF) = w; }
                        if (h2) { const f32x4 p0 = b[mm][bj][0] * gb[bj][0], p1 = b[mm][bj][1] * gb[bj][1];
                            u32x4 w; w.x = pk2(p0.x, p0.y); w.y = pk2(p0.z, p0.w); w.z = pk2(p1.x, p1.y); w.w = pk2(p1.z, p1.w); *(GAS u32x4*)(h2 + off + bj * HALF) = w; }
                    }
                    if (ss) { const int lane = fr | (fq << 4); sq += shx(sq, lane, 16); sq += shx(sq, lane, 32); if (fq == 0) atomicAdd(ss + row, sq); }
                }
            }
    }
};

template <class Epi>
DI void gemm_phase(LAS unsigned char* lds, const Gemm g, const StaticOrder& S, const Epi& E, int tid) {
    asm volatile("" : "+v"(tid)); __builtin_assume(tid >= 0 && tid < NT);
    const int wid = __builtin_amdgcn_readfirstlane(tid >> 6), lane = tid & 63, wr = wid >> 2, wc = wid & 3, fr = lane & 15, fq = lane >> 4;
    const int K = g.K, nt = K / BK;
    unsigned voffA[2], voffB[2];
#pragma unroll
    for (int i = 0; i < 2; ++i) { int R, C; stage_rc(tid * 16 + i * 8192, R, C); const int Rb = Epi::PERM ? ((R & ~31) + perm32(R & 31)) : R;
        voffA[i] = (unsigned)(R * g.dil * g.lda + C) * 2u; voffB[i] = (unsigned)(Rb * K + C) * 2u; }
    const size_t kstep = (size_t)(BK * 2);
    const size_t hstepA = (size_t)HALF * g.dil * g.lda * 2, hstepB = (size_t)HALF * K * 2, tstepB = 2 * hstepB;
    const unsigned ldsw = (unsigned)wid * 1024u;
    const int aoff = lds_byte(wr * 64 + fr, fq * 8), boff = lds_byte(wc * 32 + fr, fq * 8);
#define PG8_SA(b, h) (((b) * 2 + (h)) * HTB)
#define PG8_SB(b, h) ((4 + (b) * 2 + (h)) * HTB)
#define PG8_STAGE(bufoff, gbase, voff) do { _Pragma("unroll") for (int _i = 0; _i < 2; ++_i) \
        __builtin_amdgcn_global_load_lds((const unsigned*)((const char*)(gbase) + (voff)[_i]), (LAS unsigned*)(lds + (bufoff) + ldsw + _i * 8192), 16, 0, 0); } while (0)
#define PG8_LDA(dst, b, h) do { _Pragma("unroll") for (int m = 0; m < 4; ++m) _Pragma("unroll") for (int k = 0; k < 2; ++k) dst[m][k] = *(const LAS bf16x8*)(lds + PG8_SA(b, h) + aoff + m * 2048 + k * 1024); } while (0)
#define PG8_LDB(dst, b, h) do { _Pragma("unroll") for (int n = 0; n < 2; ++n) _Pragma("unroll") for (int k = 0; k < 2; ++k) dst[n][k] = *(const LAS bf16x8*)(lds + PG8_SB(b, h) + boff + n * 2048 + k * 1024); } while (0)
#define PG8_MMA(ai, bj, At, Bt) do { __builtin_amdgcn_s_setprio(1); _Pragma("unroll") for (int m = 0; m < 4; ++m) _Pragma("unroll") for (int n = 0; n < 2; ++n) _Pragma("unroll") for (int k = 0; k < 2; ++k) \
        acc[ai][bj][m][n] = __builtin_amdgcn_mfma_f32_16x16x32_bf16(Bt[n][k], At[m][k], acc[ai][bj][m][n], 0, 0, 0); __builtin_amdgcn_s_setprio(0); } while (0)
#define PG8_WAIT_V(n) asm volatile("s_waitcnt vmcnt(" #n ")" ::: "memory")
#define PG8_WAIT_L(n) asm volatile("s_waitcnt lgkmcnt(" #n ")" ::: "memory")
#define PG8_BAR __builtin_amdgcn_s_barrier()
#define PG8_SCHED __builtin_amdgcn_sched_barrier(0)
    Unit cur, nxt; int ui = 0;
    if (!S.next(0, cur)) return;
    LAS float* rtab_all = (LAS float*)(lds + STAGE_BYTES);
    if constexpr (Epi::USES_SS) {
        if (E.ss) {
            Unit tu;
#pragma unroll 1
            for (int i = 0; i < 8 && S.next(i, tu); ++i)
                if (tid < 256) rtab_all[i * 256 + tid] = rsqrtf(((const GAS float*)E.ss)[arow0(tu.pm, g.dil) + (size_t)tid * g.dil] * (1.f / DM) + EPS);
        }
        __syncthreads();
    }
    f32x4 acc[2][2][4][2];
#pragma unroll
    for (int a = 0; a < 2; ++a)
#pragma unroll
        for (int b = 0; b < 2; ++b)
#pragma unroll
            for (int m = 0; m < 4; ++m)
#pragma unroll
                for (int n = 0; n < 2; ++n) acc[a][b][m][n] = (f32x4){0.f, 0.f, 0.f, 0.f};
    bf16x8 At[4][2], B0[2][2], B1[2][2];
    const ptrdiff_t kend = (ptrdiff_t)(nt - 1) * (ptrdiff_t)kstep;
    ptrdiff_t kst = (ptrdiff_t)kstep;
    const char* cA = (const char*)g.A + arow0(cur.pm, g.dil) * (size_t)g.lda * 2; const char* cB = (const char*)g.Bt + (size_t)cur.pn * tstepB;
    PG8_STAGE(PG8_SB(0, 0), cB, voffB); PG8_STAGE(PG8_SB(0, 1), cB + hstepB, voffB); PG8_STAGE(PG8_SA(0, 0), cA, voffA); PG8_STAGE(PG8_SA(0, 1), cA + hstepA, voffA);
    if (wr == 1) PG8_BAR;
    PG8_WAIT_V(2); PG8_BAR;
    PG8_STAGE(PG8_SB(1, 0), cB + kst, voffB); PG8_STAGE(PG8_SA(1, 0), cA + kst, voffA); PG8_STAGE(PG8_SB(1, 1), cB + hstepB + kst, voffB);
    PG8_WAIT_V(6); PG8_BAR;
    for (;;) {
        const bool has_next = S.next(ui + 1, nxt);
        const bool nrev = has_next && ((ui + 1) & 1);
        const ptrdiff_t nkst = has_next ? (nrev ? -(ptrdiff_t)kstep : (ptrdiff_t)kstep) : kst;
        const char* nA = has_next ? (const char*)g.A + arow0(nxt.pm, g.dil) * (size_t)g.lda * 2 + (nrev ? kend : 0) : cA; const char* nB = has_next ? (const char*)g.Bt + (size_t)nxt.pn * tstepB + (nrev ? kend : 0) : cB;
        for (int t = 0; t < nt; t += 2) {
            const bool last = (t == nt - 2);
            const char* a1 = cA + (ptrdiff_t)(t + 1) * kst;
            const char* a2 = last ? nA : cA + (ptrdiff_t)(t + 2) * kst; const char* b2 = last ? nB : cB + (ptrdiff_t)(t + 2) * kst;
            const ptrdiff_t st3 = last ? nkst : kst; const char* a3 = a2 + st3; const char* b3 = b2 + st3;
            PG8_LDB(B0, 0, 0); PG8_LDB(B1, 0, 1); PG8_SCHED; PG8_LDA(At, 0, 0); PG8_STAGE(PG8_SA(1, 1), a1 + hstepA, voffA);
            PG8_WAIT_V(8); PG8_WAIT_L(0); PG8_BAR; PG8_MMA(0, 0, At, B0); PG8_MMA(0, 1, At, B1); PG8_BAR; PG8_SCHED;
            PG8_LDA(At, 0, 1); PG8_STAGE(PG8_SB(0, 0), b2, voffB); PG8_STAGE(PG8_SB(0, 1), b2 + hstepB, voffB); PG8_STAGE(PG8_SA(0, 0), a2, voffA);
            PG8_WAIT_V(8); PG8_WAIT_L(0); PG8_BAR; PG8_MMA(1, 0, At, B0); PG8_MMA(1, 1, At, B1); PG8_BAR; PG8_SCHED;
            PG8_LDB(B0, 1, 0); PG8_LDB(B1, 1, 1); PG8_SCHED; PG8_LDA(At, 1, 0); PG8_STAGE(PG8_SA(0, 1), a2 + hstepA, voffA);
            PG8_WAIT_V(8); PG8_WAIT_L(0); PG8_BAR; PG8_MMA(0, 0, At, B0); PG8_MMA(0, 1, At, B1); PG8_BAR; PG8_SCHED;
            PG8_LDA(At, 1, 1); PG8_STAGE(PG8_SB(1, 0), b3, voffB); PG8_STAGE(PG8_SB(1, 1), b3 + hstepB, voffB); PG8_STAGE(PG8_SA(1, 0), a3, voffA);
            PG8_WAIT_V(8); PG8_WAIT_L(0); PG8_BAR; PG8_MMA(1, 0, At, B0); PG8_MMA(1, 1, At, B1); PG8_BAR; PG8_SCHED;
        }
        if (wr == 0) PG8_BAR;
        E(acc, cur, wr, wc, fr, fq, ui < 8 ? rtab_all + ui * 256 : (LAS float*)nullptr);
        if (!has_next) break;
#pragma unroll
        for (int a = 0; a < 2; ++a)
#pragma unroll
            for (int b = 0; b < 2; ++b)
#pragma unroll
                for (int m = 0; m < 4; ++m)
#pragma unroll
                    for (int n = 0; n < 2; ++n) acc[a][b][m][n] = (f32x4){0.f, 0.f, 0.f, 0.f};
        cur = nxt; cA = nA; cB = nB; kst = nkst; ++ui;
        if (wr == 1) PG8_BAR;
    }
    PG8_WAIT_V(0);
    PG8_BAR;
#undef PG8_SA
#undef PG8_SB
#undef PG8_STAGE
#undef PG8_LDA
#undef PG8_LDB
#undef PG8_MMA
#undef PG8_WAIT_V
#undef PG8_WAIT_L
#undef PG8_BAR
#undef PG8_SCHED
}
}

template <int NCH, int CPR>
DI void load_rows(LAS unsigned char* dst, int dstride, const bf16_t* src, size_t ld, int zrows, int tid) {
    u32x4 v[NCH];
#pragma unroll
    for (int j = 0; j < NCH; ++j) { const int c = tid + NT * j, row = c / CPR, ch = c % CPR;
        v[j] = (u32x4){0u, 0u, 0u, 0u};
        if (row >= zrows) v[j] = *(const GAS u32x4*)(src + (ptrdiff_t)row * (ptrdiff_t)ld + ch * 8); }
#pragma unroll
    for (int j = 0; j < NCH; ++j) { const int c = tid + NT * j, row = c / CPR, ch = c % CPR;
        *(LAS u32x4*)(dst + row * dstride + ch * 16) = v[j]; }
}
template <int NCH, int CPR>
DI void ld_issue(u32x4 (&v)[NCH], const bf16_t* src, size_t ld, int zrows, int tid) {
#pragma unroll
    for (int j = 0; j < NCH; ++j) { const int c = tid + NT * j, row = c / CPR, ch = c % CPR;
        v[j] = (u32x4){0u, 0u, 0u, 0u};
        if (row >= zrows) v[j] = *(const GAS u32x4*)(src + (ptrdiff_t)row * (ptrdiff_t)ld + ch * 8); }
}
template <int NCH, int CPR>
DI void ld_commit(LAS unsigned char* dst, int dstride, const u32x4 (&v)[NCH], int tid) {
#pragma unroll
    for (int j = 0; j < NCH; ++j) { const int c = tid + NT * j, row = c / CPR, ch = c % CPR;
        *(LAS u32x4*)(dst + row * dstride + ch * 16) = v[j]; }
}
template <bool ZETA>
DI void load_rot(LAS unsigned char* dst, int dstride, const bf16_t* src, size_t ld, const float* cosT, const float* sinT, int pos0, float scale, float log2g, int tid) {
#pragma unroll
    for (int j = 0; j < 2; ++j) {
        const int c = tid + NT * j, row = c >> 3, ch = c & 7;
        const bf16_t* p = src + (size_t)row * ld + ch * 8;
        const u32x4 a = *(const GAS u32x4*)p, b = *(const GAS u32x4*)(p + 64);
        const float* cp = cosT + (size_t)(pos0 + row) * 64 + ch * 8; const float* sp = sinT + (size_t)(pos0 + row) * 64 + ch * 8;
        const f32x4 c0 = *(const GAS f32x4*)cp, c1 = *(const GAS f32x4*)(cp + 4), s0 = *(const GAS f32x4*)sp, s1 = *(const GAS f32x4*)(sp + 4);
        float f = scale; if (ZETA) f *= exp2f((float)(127 - row) * log2g);
        u32x4 o1, o2;
#pragma unroll
        for (int k = 0; k < 4; ++k) {
            const float x1a = bflo(a[k]), x1b = bfhi(a[k]), x2a = bflo(b[k]), x2b = bfhi(b[k]);
            const float ca = (k < 2) ? c0[2 * k] : c1[2 * k - 4], cb = (k < 2) ? c0[2 * k + 1] : c1[2 * k - 3];
            const float sa = (k < 2) ? s0[2 * k] : s1[2 * k - 4], sb = (k < 2) ? s0[2 * k + 1] : s1[2 * k - 3];
            o1[k] = pk2((x1a * ca - x2a * sa) * f, (x1b * cb - x2b * sb) * f);
            o2[k] = pk2((x1a * sa + x2a * ca) * f, (x1b * sb + x2b * cb) * f);
        }
        *(LAS u32x4*)(dst + row * dstride + ch * 16) = o1;
        *(LAS u32x4*)(dst + row * dstride + 128 + ch * 16) = o2;
    }
}

DI void transpose_seg(const float* W, int K, int N, int nsrc0, int ncols, bf16_t* WT, int drow0, LAS float* scr, int gw, int ngw, int lane) {
    const int nblk = ncols / 64, nitems = (K / 64) * nblk;
    const int kk4 = lane >> 4, c4 = (lane & 15) * 4, c = lane & 7, n8 = lane >> 3;
    for (int item = gw; item < nitems; item += ngw) {
        const int kb = item / nblk, nb = item % nblk, k0 = 64 * kb, n0 = 64 * nb;
        const float* src = W + (size_t)(k0 + kk4) * N + nsrc0 + n0 + c4;
        f32x4 v[16];
#pragma unroll
        for (int i = 0; i < 16; ++i) v[i] = *(const GAS f32x4*)(src + (size_t)(4 * i) * N);
#pragma unroll
        for (int i = 0; i < 16; ++i) { LAS float* d = scr + (4 * i + kk4) * 65 + c4; d[0] = v[i].x; d[1] = v[i].y; d[2] = v[i].z; d[3] = v[i].w; }
        asm volatile("s_waitcnt lgkmcnt(0)" ::: "memory");
#pragma unroll
        for (int j = 0; j < 8; ++j) { const int n = n8 + 8 * j; const LAS float* s = scr + (8 * c) * 65 + n;
            u32x4 o; o.x = pk2(s[0 * 65], s[1 * 65]); o.y = pk2(s[2 * 65], s[3 * 65]); o.z = pk2(s[4 * 65], s[5 * 65]); o.w = pk2(s[6 * 65], s[7 * 65]);
            *(GAS u32x4*)(WT + (size_t)(drow0 + n0 + n) * K + k0 + 8 * c) = o; }
        asm volatile("s_waitcnt lgkmcnt(0)" ::: "memory");
    }
}
DI void norm_row_bf16(const float* xr, const float* g, bf16_t* o, int lane) {
    f32x4 v[8]; float s = 0.f;
#pragma unroll
    for (int j = 0; j < 8; ++j) { v[j] = ((const GAS f32x4*)xr)[lane + 64 * j]; s += (v[j].x * v[j].x + v[j].y * v[j].y) + (v[j].z * v[j].z + v[j].w * v[j].w); }
    const float rstd = rsqrtf(wave_sum(s, lane) * (1.f / DM) + EPS);
#pragma unroll
    for (int j = 0; j < 8; ++j) { const f32x4 gg = ((const GAS f32x4*)g)[lane + 64 * j];
        u32x2 w; w.x = pk2(v[j].x * rstd * gg.x, v[j].y * rstd * gg.y); w.y = pk2(v[j].z * rstd * gg.z, v[j].w * rstd * gg.w);
        ((GAS u32x2*)o)[lane + 64 * j] = w; }
}
DI void norm_rows(const float* x, const float* g, bf16_t* o, int nrows, int gw, int ngw, int lane) {
    for (int m = gw; m < nrows; m += ngw) norm_row_bf16(x + (size_t)m * DM, g, o + (size_t)m * DM, lane);
}

struct StRaw { u32x4 ka[2], kb[2], vv[2]; f32x4 c0[2], c1[2], s0[2], s1[2]; };
DI void st_issue(StRaw& r, const bf16_t* projA, const float* cosT, const float* sinT, int b, int hh, int es, int n, int tid) {
    const size_t row0 = (size_t)b * SEQ + n * 128;
#pragma unroll
    for (int j = 0; j < 2; ++j) {
        const int c = tid + NT * j, row = c >> 3, ch = c & 7;
        const bf16_t* p = projA + (row0 + row) * 8192 + 1024 + hh * 128 + ch * 8;
        r.ka[j] = *(const GAS u32x4*)p; r.kb[j] = *(const GAS u32x4*)(p + 64);
        const float* cp = cosT + (size_t)(n * 128 + row) * 64 + ch * 8; const float* sp = sinT + (size_t)(n * 128 + row) * 64 + ch * 8;
        r.c0[j] = *(const GAS f32x4*)cp; r.c1[j] = *(const GAS f32x4*)(cp + 4); r.s0[j] = *(const GAS f32x4*)sp; r.s1[j] = *(const GAS f32x4*)(sp + 4);
        r.vv[j] = *(const GAS u32x4*)(projA + (row0 + row) * 8192 + 2048 + hh * 256 + 64 * es + ch * 8);
    }
}
DI void st_commit(const StRaw& r, LAS unsigned char* Kz, LAS unsigned char* Vz, float log2g, int tid) {
#pragma unroll
    for (int j = 0; j < 2; ++j) {
        const int c = tid + NT * j, row = c >> 3, ch = c & 7;
        const float f = 0.08838834764831845f * exp2f((float)(127 - row) * log2g);
        const u32x4 a = r.ka[j], b = r.kb[j]; const f32x4 c0 = r.c0[j], c1 = r.c1[j], s0 = r.s0[j], s1 = r.s1[j];
        u32x4 o1, o2;
#pragma unroll
        for (int k = 0; k < 4; ++k) {
            const float x1a = bflo(a[k]), x1b = bfhi(a[k]), x2a = bflo(b[k]), x2b = bfhi(b[k]);
            const float ca = (k < 2) ? c0[2 * k] : c1[2 * k - 4], cb = (k < 2) ? c0[2 * k + 1] : c1[2 * k - 3];
            const float sa = (k < 2) ? s0[2 * k] : s1[2 * k - 4], sb = (k < 2) ? s0[2 * k + 1] : s1[2 * k - 3];
            o1[k] = pk2((x1a * ca - x2a * sa) * f, (x1b * cb - x2b * sb) * f);
            o2[k] = pk2((x1a * sa + x2a * ca) * f, (x1b * sb + x2b * cb) * f);
        }
        *(LAS u32x4*)(Kz + row * 320 + ch * 16) = o1;
        *(LAS u32x4*)(Kz + row * 320 + 128 + ch * 16) = o2;
        *(LAS u32x4*)(Vz + row * 192 + ch * 16) = r.vv[j];
    }
}
DI void ret_state_item(LAS unsigned char* lds, const bf16_t* projA, bf16_t* rprev, const float* cosT, const float* sinT, int item, int tid) {
    asm volatile("" : "+v"(tid)); __builtin_assume(tid >= 0 && tid < NT);
    const int lane = tid & 63, w = __builtin_amdgcn_readfirstlane(tid >> 6), h = lane >> 5, blk = (lane >> 4) & 1, q4 = (lane & 15) >> 2, p4 = lane & 3;
    const int es = item & 3, hh = (item >> 2) & 7, b = item >> 5;
    const int et = w & 1, dt = w >> 1;
    const float log2g = log2f(1.f - exp2f(-5.f - (float)hh));
    const float gchunk = exp2f(128.f * log2g);
    f32x16 acc = zero16();
    StRaw ra, rb;
    st_issue(ra, projA, cosT, sinT, b, hh, es, 0, tid);
    st_issue(rb, projA, cosT, sinT, b, hh, es, 1, tid);
#define ST_STEP(RAW, N)                                                                                                            \
    {   bf16_t* rp = rprev + ((size_t)((b * 8 + hh) * 32 + (N)) * 256 + 64 * es + 32 * et) * 128 + 32 * dt + (lane & 31);           \
        _Pragma("unroll") for (int i = 0; i < 16; ++i) ((GAS bf16_t*)rp)[(size_t)crow(i, h) * 128] = (bf16_t)(pk2(acc[i], 0.f) & 0xffffu);   \
        if ((N) == 31) break;                                                                                                      \
        LAS unsigned char* Kz = lds + ((N) & 1) * 65536;                                                                           \
        LAS unsigned char* Vz = Kz + 128 * 320;                                                                                    \
        st_commit(RAW, Kz, Vz, log2g, tid);                                                                                        \
        if ((N) + 2 <= 30) st_issue(RAW, projA, cosT, sinT, b, hh, es, (N) + 2, tid);                                              \
        lds_barrier();                                                                                                             \
        _Pragma("unroll") for (int i = 0; i < 16; ++i) acc[i] *= gchunk;                                                           \
        _Pragma("unroll") for (int ks = 0; ks < 8; ++ks) {                                                                         \
            const int r0 = 16 * ks + 8 * h + q4;                                                                                   \
            const bf16x8 a = tr_pair(Vz + r0 * 192 + (32 * et + 16 * blk + 4 * p4) * 2, Vz + (r0 + 4) * 192 + (32 * et + 16 * blk + 4 * p4) * 2);   \
            const bf16x8 bb = tr_pair(Kz + r0 * 320 + (32 * dt + 16 * blk + 4 * p4) * 2, Kz + (r0 + 4) * 320 + (32 * dt + 16 * blk + 4 * p4) * 2); \
            acc = MFMA32(a, bb, acc);                                                                                              \
        } }
#pragma unroll 1
    for (int n = 0; n < 32; n += 2) {
        ST_STEP(ra, n)
        ST_STEP(rb, n + 1)
    }
#undef ST_STEP
    lds_barrier();
}

DI void ret_out_item(LAS unsigned char* lds, const bf16_t* projA, const bf16_t* rprev, bf16_t* mix, const float* cosT, const float* sinT, int item, int tid) {
    asm volatile("" : "+v"(tid)); __builtin_assume(tid >= 0 && tid < NT);
    const int lane = tid & 63, w = __builtin_amdgcn_readfirstlane(tid >> 6), h = lane >> 5, blk = (lane >> 4) & 1, q4 = (lane & 15) >> 2, p4 = lane & 3, ql = lane & 31;
    const int n = item & 31, hh = (item >> 5) & 7, b = item >> 8;
    const int qsub = w & 3, eh = w >> 2;
    const float log2g = log2f(1.f - exp2f(-5.f - (float)hh));
    LAS unsigned char* Qs = lds;
    LAS unsigned char* Ks = lds + 34816;
    LAS unsigned char* Rs = lds + 69632;
    LAS unsigned char* Vs = lds;
    LAS float* red = (LAS float*)(lds + 139264);
    const size_t row0 = (size_t)b * SEQ + n * 128;
    lds_barrier();
    load_rot<false>(Qs, 272, projA + row0 * 8192 + hh * 128, 8192, cosT, sinT, n * 128, 1.f, 0.f, tid);
    load_rot<false>(Ks, 272, projA + row0 * 8192 + 1024 + hh * 128, 8192, cosT, sinT, n * 128, 0.08838834764831845f, 0.f, tid);
    load_rows<8, 16>(Rs, 272, rprev + (size_t)((b * 8 + hh) * 32 + n) * 256 * 128, 128, 0, tid);
    lds_barrier();
    u32x4 vreg[8];
    ld_issue<8, 32>(vreg, projA + row0 * 8192 + 2048 + hh * 256, 8192, 0, tid);
    __builtin_amdgcn_sched_barrier(0);
    bf16x8 qf[8];
#pragma unroll
    for (int ks = 0; ks < 8; ++ks) qf[ks] = *(const LAS bf16x8*)(Qs + (32 * qsub + ql) * 272 + (16 * ks + 8 * h) * 2);
    bf16x8 pf[4][2];
#pragma unroll
    for (int kt = 0; kt < 4; ++kt) {
        if (kt <= qsub) {
            f32x16 s = zero16();
#pragma unroll
            for (int ks = 0; ks < 8; ++ks) { const bf16x8 a = *(const LAS bf16x8*)(Ks + (32 * kt + ql) * 272 + (16 * ks + 8 * h) * 2); s = MFMA32(a, qf[ks], s); }
#pragma unroll
            for (int i = 0; i < 16; ++i) { const int dq = (32 * qsub + ql) - (32 * kt + crow(i, h)); s[i] = (dq >= 0) ? s[i] * __builtin_amdgcn_exp2f((float)dq * log2g) : 0.f; }
            pf[kt][0] = pack8<0>(s); pf[kt][1] = pack8<1>(s);
            __builtin_amdgcn_sched_barrier(0);
        } else { pf[kt][0] = (bf16x8){0, 0, 0, 0, 0, 0, 0, 0}; pf[kt][1] = pf[kt][0]; }
    }
    f32x16 o[4];
    const float xi = exp2f((float)(32 * qsub + ql + 1) * log2g);
#pragma unroll
    for (int et = 0; et < 4; ++et) {
        o[et] = zero16();
#pragma unroll
        for (int ks = 0; ks < 8; ++ks) { const bf16x8 a = *(const LAS bf16x8*)(Rs + (128 * eh + 32 * et + ql) * 272 + (16 * ks + 8 * h) * 2); o[et] = MFMA32(a, qf[ks], o[et]); }
#pragma unroll
        for (int i = 0; i < 16; ++i) o[et][i] *= xi;
    }
    lds_barrier();
    ld_commit<8, 32>(Vs, 576, vreg, tid);
    lds_barrier();
#pragma unroll
    for (int et = 0; et < 4; ++et)
#pragma unroll
        for (int kt = 0; kt < 4; ++kt)
            if (kt <= qsub) {
#pragma unroll
                for (int s = 0; s < 2; ++s) {
                    const int r0 = 32 * kt + 16 * s + 4 * h + q4; const int cb = (128 * eh + 32 * et + 16 * blk + 4 * p4) * 2;
                    const bf16x8 a = tr_pair(Vs + r0 * 576 + cb, Vs + (r0 + 8) * 576 + cb);
                    o[et] = MFMA32(a, pf[kt][s], o[et]);
                }
            }
    float ss = 0.f;
#pragma unroll
    for (int et = 0; et < 4; ++et)
#pragma unroll
        for (int i = 0; i < 16; ++i) ss += o[et][i] * o[et][i];
    ss += shx(ss, lane, 32);
    if (h == 0) red[eh * 128 + 32 * qsub + ql] = ss;
    lds_barrier();
    const float tot = red[32 * qsub + ql] + red[128 + 32 * qsub + ql];
    const float rstd = rsqrtf(tot * (1.f / 256.f) + EPS);
    const size_t tok = row0 + 32 * qsub + ql;
    const bf16_t* gp = projA + tok * 8192 + 4096 + hh * 256 + 128 * eh + 4 * h;
    bf16_t* op = mix + tok * 3072 + hh * 256 + 128 * eh + 4 * h;
    u32x2 gvv[4][4];
#pragma unroll
    for (int et = 0; et < 4; ++et)
#pragma unroll
        for (int i4 = 0; i4 < 4; ++i4) gvv[et][i4] = *(const GAS u32x2*)(gp + 32 * et + 8 * i4);
#pragma unroll
    for (int et = 0; et < 4; ++et)
#pragma unroll
        for (int i4 = 0; i4 < 4; ++i4) {
            const u32x2 gv = gvv[et][i4];
            u32x2 wv;
            wv.x = pk2(o[et][4 * i4] * rstd * silu_f(bflo(gv.x)), o[et][4 * i4 + 1] * rstd * silu_f(bfhi(gv.x)));
            wv.y = pk2(o[et][4 * i4 + 2] * rstd * silu_f(bflo(gv.y)), o[et][4 * i4 + 3] * rstd * silu_f(bfhi(gv.y)));
            *(GAS u32x2*)(op + 32 * et + 8 * i4) = wv;
        }
}

DI void mem_attn_item(LAS unsigned char* lds, const bf16_t* qp, size_t ldq, const bf16_t* gatep, size_t ldg, bf16_t* outp, size_t ldo,
                      const bf16_t* kmem, const bf16_t* vmem, int tid, int eh_sel = -1) {
    asm volatile("" : "+v"(tid)); __builtin_assume(tid >= 0 && tid < NT);
    const int lane = tid & 63, w = __builtin_amdgcn_readfirstlane(tid >> 6), h = lane >> 5, blk = (lane >> 4) & 1, q4 = (lane & 15) >> 2, p4 = lane & 3, ql = lane & 31;
    LAS unsigned char* Ks = lds;
    LAS unsigned char* Vs = lds;
    lds_barrier();
    load_rows<16, 32>(Ks, 528, kmem, 8192, 0, tid);
    lds_barrier();
    const int eh_lo = (eh_sel < 0) ? 0 : eh_sel, eh_hi = (eh_sel < 0) ? 2 : eh_sel + 1;
    u32x4 vreg[8];
    ld_issue<8, 16>(vreg, vmem + 128 * eh_lo, 8192, 0, tid);
    __builtin_amdgcn_sched_barrier(0);
    const bf16_t* qrow = qp + (size_t)(32 * w + ql) * ldq + 8 * h;
    f32x16 s[8];
#pragma unroll
    for (int kt = 0; kt < 8; ++kt) s[kt] = zero16();
#pragma unroll
    for (int dh = 0; dh < 2; ++dh) {
        bf16x8 qf[8];
#pragma unroll
        for (int ks = 0; ks < 8; ++ks) qf[ks] = *(const GAS bf16x8*)(qrow + 128 * dh + 16 * ks);
#pragma unroll
        for (int kt = 0; kt < 8; ++kt)
#pragma unroll
            for (int ks = 0; ks < 8; ++ks) { const bf16x8 a = *(const LAS bf16x8*)(Ks + (32 * kt + ql) * 528 + (128 * dh + 16 * ks + 8 * h) * 2); s[kt] = MFMA32(a, qf[ks], s[kt]); }
    }
    const float c = 0.0625f * LOG2E;
    float m = -3.0e38f;
#pragma unroll
    for (int kt = 0; kt < 8; ++kt)
#pragma unroll
        for (int i = 0; i < 16; ++i) { s[kt][i] *= c; m = fmaxf(m, s[kt][i]); }
    m = fmaxf(m, shx(m, lane, 32));
    float l = 0.f;
    bf16x8 pf[8][2];
#pragma unroll
    for (int kt = 0; kt < 8; ++kt) {
#pragma unroll
        for (int i = 0; i < 16; ++i) { s[kt][i] = __builtin_amdgcn_exp2f(s[kt][i] - m); l += s[kt][i]; }
        pf[kt][0] = pack8<0>(s[kt]); pf[kt][1] = pack8<1>(s[kt]);
        __builtin_amdgcn_sched_barrier(0);
    }
    l += shx(l, lane, 32);
    const float rl = 1.f / l;
#pragma unroll 1
    for (int eh = eh_lo; eh < eh_hi; ++eh) {
        lds_barrier();
        ld_commit<8, 16>(Vs, 320, vreg, tid);
        if (eh + 1 < eh_hi) ld_issue<8, 16>(vreg, vmem + 128 * (eh + 1), 8192, 0, tid);
        lds_barrier();
        f32x16 o[4];
#pragma unroll
        for (int et = 0; et < 4; ++et) {
            o[et] = zero16();
#pragma unroll
            for (int kt = 0; kt < 8; ++kt)
#pragma unroll
                for (int sx = 0; sx < 2; ++sx) {
                    const int r0 = 32 * kt + 16 * sx + 4 * h + q4; const int cb = (32 * et + 16 * blk + 4 * p4) * 2;
                    const bf16x8 a = tr_pair(Vs + r0 * 320 + cb, Vs + (r0 + 8) * 320 + cb);
                    o[et] = MFMA32(a, pf[kt][sx], o[et]);
                }
        }
        const bf16_t* gp = gatep + (size_t)(32 * w + ql) * ldg + 128 * eh + 4 * h;
        bf16_t* op = outp + (size_t)(32 * w + ql) * ldo + 128 * eh + 4 * h;
        u32x2 gvv[4][4];
#pragma unroll
        for (int et = 0; et < 4; ++et)
#pragma unroll
            for (int i4 = 0; i4 < 4; ++i4) gvv[et][i4] = *(const GAS u32x2*)(gp + 32 * et + 8 * i4);
#pragma unroll
        for (int et = 0; et < 4; ++et)
#pragma unroll
            for (int i4 = 0; i4 < 4; ++i4) {
                const u32x2 gv = gvv[et][i4];
                u32x2 wv;
                wv.x = pk2(o[et][4 * i4] * rl * silu_f(bflo(gv.x)), o[et][4 * i4 + 1] * rl * silu_f(bfhi(gv.x)));
                wv.y = pk2(o[et][4 * i4 + 2] * rl * silu_f(bflo(gv.y)), o[et][4 * i4 + 3] * rl * silu_f(bfhi(gv.y)));
                *(GAS u32x2*)(op + 32 * et + 8 * i4) = wv;
            }
    }
}

DI void dil_attn_item(LAS unsigned char* lds, bf16_t* qp, size_t ldq, const bf16_t* kp, const bf16_t* vp, float* lsep  , int i0, int tid, bool dry = false) {
    asm volatile("" : "+v"(tid)); __builtin_assume(tid >= 0 && tid < NT);
    const int lane = tid & 63, w = __builtin_amdgcn_readfirstlane(tid >> 6), h = lane >> 5, blk = (lane >> 4) & 1, q4 = (lane & 15) >> 2, p4 = lane & 3, ql = lane & 31;
    LAS unsigned char* Ks = lds;
    LAS unsigned char* Vs = lds;
    const int zr = (i0 == 0) ? 128 : 0;
    __syncthreads();
    load_rows<12, 16>(Ks, 272, kp - (ptrdiff_t)128 * 128, 128, zr, tid);
    bf16x8 qf[8];
    bf16_t* qrow = qp + (size_t)(32 * w + ql) * ldq;
#pragma unroll
    for (int ks = 0; ks < 8; ++ks) qf[ks] = *(const GAS bf16x8*)(qrow + 16 * ks + 8 * h);
    __syncthreads();
    u32x4 vreg[12];
    ld_issue<12, 16>(vreg, vp - (ptrdiff_t)128 * 128, 128, zr, tid);
    __builtin_amdgcn_sched_barrier(0);
    f32x16 s[5];
#pragma unroll
    for (int kt = 0; kt < 5; ++kt) {
        s[kt] = zero16();
#pragma unroll
        for (int ks = 0; ks < 8; ++ks) { const bf16x8 a = *(const LAS bf16x8*)(Ks + (32 * w + 32 * kt + ql) * 272 + (16 * ks + 8 * h) * 2); s[kt] = MFMA32(a, qf[ks], s[kt]); }
    }
    const float c = 0.08838834764831845f * LOG2E;
    float m = -3.0e38f;
#pragma unroll
    for (int kt = 0; kt < 5; ++kt)
#pragma unroll
        for (int i = 0; i < 16; ++i) {
            const int kr = crow(i, h);
            bool valid = true;
            if (kt == 0) valid = (kr >= ql);
            if (kt == 4) valid = (kr <= ql);
            if (zr) valid = valid && (32 * w + 32 * kt + kr >= 128);
            s[kt][i] = valid ? s[kt][i] * c : -3.0e38f;
            m = fmaxf(m, s[kt][i]);
        }
    m = fmaxf(m, shx(m, lane, 32));
    float l = 0.f;
    bf16x8 pf[5][2];
#pragma unroll
    for (int kt = 0; kt < 5; ++kt) {
#pragma unroll
        for (int i = 0; i < 16; ++i) { s[kt][i] = __builtin_amdgcn_exp2f(s[kt][i] - m); l += s[kt][i]; }
        pf[kt][0] = pack8<0>(s[kt]); pf[kt][1] = pack8<1>(s[kt]);
        __builtin_amdgcn_sched_barrier(0);
    }
    l += shx(l, lane, 32);
    const float rl = 1.f / l;
    __syncthreads();
    ld_commit<12, 16>(Vs, 320, vreg, tid);
    __syncthreads();
    f32x16 o[4];
#pragma unroll
    for (int dt = 0; dt < 4; ++dt) {
        o[dt] = zero16();
#pragma unroll
        for (int kt = 0; kt < 5; ++kt)
#pragma unroll
            for (int sx = 0; sx < 2; ++sx) {
                const int r0 = 32 * w + 32 * kt + 16 * sx + 4 * h + q4; const int cb = (32 * dt + 16 * blk + 4 * p4) * 2;
                const bf16x8 a = tr_pair(Vs + r0 * 320 + cb, Vs + (r0 + 8) * 320 + cb);
                o[dt] = MFMA32(a, pf[kt][sx], o[dt]);
            }
    }
#pragma unroll
    for (int dt = 0; dt < 4; ++dt)
#pragma unroll
        for (int i4 = 0; i4 < 4; ++i4) {
            u32x2 wv; wv.x = pk2(o[dt][4 * i4] * rl, o[dt][4 * i4 + 1] * rl); wv.y = pk2(o[dt][4 * i4 + 2] * rl, o[dt][4 * i4 + 3] * rl);
            if (!dry) *(GAS u32x2*)(qrow + 32 * dt + 8 * i4 + 4 * h) = wv;
        }
    if (h == 0 && !dry) lsep[(size_t)(32 * w + ql) * 16] = m * LN2 + __logf(l);
}

struct DilItem { bf16_t* qp; const bf16_t* kp; const bf16_t* vp; float* lsep; int zr; };
DI DilItem dil_decode(unsigned char* ws, int hb, int it) {
    const int head = it & 15, blkr = (it >> 4) & 31, gi = it >> 9;
    const int n = (gi == 0) ? 4096 : (gi == 1 ? 1024 : 256);
    const int colq = (gi == 0) ? 0 : (gi == 1 ? 6144 : 8192);
    const int ml0 = blkr * 256, i0 = (ml0 & 4095) % n; const size_t mg0 = (size_t)hb * 8192 + ml0;
    const bf16_t* kvg = (bf16_t*)(ws + WS_KV) + (size_t)gi * T_TOK * 4096;
    DilItem d;
    d.qp = (bf16_t*)(ws + WS_P) + (size_t)ml0 * 10240 + colq + head * 128;
    d.kp = kvg + ((size_t)head * T_TOK + mg0) * 128 - (ptrdiff_t)128 * 128;
    d.vp = kvg + ((size_t)(16 + head) * T_TOK + mg0) * 128 - (ptrdiff_t)128 * 128;
    d.lsep = (float*)(ws + WS_LSE) + ((size_t)gi * 8192 + ml0) * 16 + head;
    d.zr = (i0 == 0) ? 128 : 0;
    return d;
}
DI void dil_attn_phase(LAS unsigned char* lds, unsigned char* ws, int hb, int it_begin, int it_end, bool merge, int bid, int G, int tid) {
    asm volatile("" : "+v"(tid)); __builtin_assume(tid >= 0 && tid < NT);
    const int lane = tid & 63, w = __builtin_amdgcn_readfirstlane(tid >> 6), h = lane >> 5, blk = (lane >> 4) & 1, q4 = (lane & 15) >> 2, p4 = lane & 3, ql = lane & 31;
    LAS unsigned char* Ks = lds;
    LAS unsigned char* Vs = lds;
    if (it_begin + bid >= it_end) return;
    DilItem cur = dil_decode(ws, hb, it_begin + bid);
    u32x4 kvreg[12];
    bf16x8 qf[8];
    ld_issue<12, 16>(kvreg, cur.kp, 128, cur.zr, tid);
#pragma unroll 1
    for (int it = it_begin + bid; it < it_end; it += G) {
        const bool has_next = (it + G) < it_end;
        DilItem nxt = cur; if (has_next) nxt = dil_decode(ws, hb, it + G);
        bf16_t* orow = cur.qp + (size_t)(32 * w + ql) * 10240;
#pragma unroll
        for (int ks = 0; ks < 8; ++ks) qf[ks] = *(const GAS bf16x8*)(orow + 16 * ks + 8 * h);
        lds_barrier();
        ld_commit<12, 16>(Ks, 272, kvreg, tid);
        ld_issue<12, 16>(kvreg, cur.vp, 128, cur.zr, tid);
        lds_barrier();
        f32x16 s[5];
#pragma unroll
        for (int kt = 0; kt < 5; ++kt) {
            s[kt] = zero16();
#pragma unroll
            for (int ks = 0; ks < 8; ++ks) { const bf16x8 a = *(const LAS bf16x8*)(Ks + (32 * w + 32 * kt + ql) * 272 + (16 * ks + 8 * h) * 2); s[kt] = MFMA32(a, qf[ks], s[kt]); }
        }
        const float c = 0.08838834764831845f * LOG2E;
        float m = -3.0e38f;
#pragma unroll
        for (int kt = 0; kt < 5; ++kt)
#pragma unroll
            for (int i = 0; i < 16; ++i) {
                const int kr = crow(i, h);
                bool valid = true;
                if (kt == 0) valid = (kr >= ql);
                if (kt == 4) valid = (kr <= ql);
                if (cur.zr) valid = valid && (32 * w + 32 * kt + kr >= 128);
                s[kt][i] = valid ? s[kt][i] * c : -3.0e38f;
                m = fmaxf(m, s[kt][i]);
            }
        m = fmaxf(m, shx(m, lane, 32));
        float l = 0.f;
        bf16x8 pf[5][2];
#pragma unroll
        for (int kt = 0; kt < 5; ++kt) {
#pragma unroll
            for (int i = 0; i < 16; ++i) { s[kt][i] = __builtin_amdgcn_exp2f(s[kt][i] - m); l += s[kt][i]; }
            pf[kt][0] = pack8<0>(s[kt]); pf[kt][1] = pack8<1>(s[kt]);
            __builtin_amdgcn_sched_barrier(0);
        }
        l += shx(l, lane, 32);
        const float rl = 1.f / l;
        lds_barrier();
        ld_commit<12, 16>(Vs, 320, kvreg, tid);
        lds_barrier();
        f32x16 o[4];
#pragma unroll
        for (int dt = 0; dt < 4; ++dt) {
            o[dt] = zero16();
#pragma unroll
            for (int kt = 0; kt < 5; ++kt)
#pragma unroll
                for (int sx = 0; sx < 2; ++sx) {
                    const int r0 = 32 * w + 32 * kt + 16 * sx + 4 * h + q4; const int cb = (32 * dt + 16 * blk + 4 * p4) * 2;
                    const bf16x8 a = tr_pair(Vs + r0 * 320 + cb, Vs + (r0 + 8) * 320 + cb);
                    o[dt] = MFMA32(a, pf[kt][sx], o[dt]);
                }
        }
        __builtin_amdgcn_sched_barrier(0);
        if (has_next) ld_issue<12, 16>(kvreg, nxt.kp, 128, nxt.zr, tid);
        lds_barrier();
        LAS unsigned char* stg = lds + w * (32 * 272);
#pragma unroll
        for (int dt = 0; dt < 4; ++dt)
#pragma unroll
            for (int i4 = 0; i4 < 4; ++i4) {
                u32x2 wv; wv.x = pk2(o[dt][4 * i4] * rl, o[dt][4 * i4 + 1] * rl); wv.y = pk2(o[dt][4 * i4 + 2] * rl, o[dt][4 * i4 + 3] * rl);
                *(LAS u32x2*)(stg + ql * 272 + (32 * dt + 8 * i4 + 4 * h) * 2) = wv;
            }
        const float lse_q = m * LN2 + __logf(l);
        LAS float* stgl = (LAS float*)(lds + 8 * (32 * 272)) + w * 32;
        if (!merge) { if (h == 0) ((GAS float*)cur.lsep)[(size_t)(32 * w + ql) * 16] = lse_q; }
        else if (h == 0) stgl[ql] = lse_q;
        if (!merge) {
            bf16_t* ob = cur.qp + (size_t)(32 * w) * 10240;
            bf16_t* op = ob + (size_t)(lane >> 4) * 10240 + (lane & 15) * 8; LAS unsigned char* sp = stg + (lane >> 4) * 272 + (lane & 15) * 16;
#pragma unroll 2
            for (int j = 0; j < 8; ++j) { *(GAS u32x4*)op = *(const LAS u32x4*)sp; op += 4 * 10240; sp += 4 * 272; }
        } else {
            bf16_t* pB = (bf16_t*)(ws + WS_P); const float* lse = (const float*)(ws + WS_LSE);
            const int hd = (int)((cur.qp - pB) % 10240) >> 7;
            const int ml0 = (int)((cur.qp - pB) / 10240);
#pragma unroll 1
            for (int jb = 0; jb < 8; jb += 4) {
                u32x4 v1a[4], v2a[4], gva[4]; float l1a[4], l2a[4];
#pragma unroll
                for (int jj = 0; jj < 4; ++jj) {
                    const int r = (lane >> 4) + 4 * (jb + jj), c8 = (lane & 15) * 8;
                    const int tl = ml0 + 32 * w + r, b = tl >> 12, ti = tl & 4095;
                    const int m1 = b * 4096 + (ti & 3) * 1024 + (ti >> 2), m2 = b * 4096 + (ti & 15) * 256 + (ti >> 4);
                    l1a[jj] = ((const GAS float*)lse)[((size_t)8192 + m1) * 16 + hd]; l2a[jj] = ((const GAS float*)lse)[((size_t)16384 + m2) * 16 + hd];
                    v1a[jj] = *(const GAS u32x4*)(pB + (size_t)m1 * 10240 + 6144 + hd * 128 + c8); v2a[jj] = *(const GAS u32x4*)(pB + (size_t)m2 * 10240 + 8192 + hd * 128 + c8);
                    gva[jj] = *(const GAS u32x4*)(pB + (size_t)tl * 10240 + hd * 128 + c8 + 4096);
                }
#pragma unroll
                for (int jj = 0; jj < 4; ++jj) {
                    const int r = (lane >> 4) + 4 * (jb + jj), c8 = (lane & 15) * 8;
                    const int tl = ml0 + 32 * w + r;
                    const float l0 = stgl[r], l1 = l1a[jj], l2 = l2a[jj];
                    const u32x4 v0 = *(const LAS u32x4*)(stg + r * 272 + (lane & 15) * 16);
                    const u32x4 v1 = v1a[jj], v2 = v2a[jj], gv = gva[jj];
                    bf16_t* orow0 = pB + (size_t)tl * 10240 + hd * 128 + c8;
                    const float mx = fmaxf(l0, fmaxf(l1, l2));
                    float a0 = __expf(l0 - mx), a1 = __expf(l1 - mx), a2 = __expf(l2 - mx); const float rs = 1.f / (a0 + a1 + a2); a0 *= rs; a1 *= rs; a2 *= rs;
                    u32x4 ov;
#pragma unroll
                    for (int k = 0; k < 4; ++k) {
                        const float ea = a0 * bflo(v0[k]) + a1 * bflo(v1[k]) + a2 * bflo(v2[k]), eb = a0 * bfhi(v0[k]) + a1 * bfhi(v1[k]) + a2 * bfhi(v2[k]);
                        ov[k] = pk2(ea * silu_f(bflo(gv[k])), eb * silu_f(bfhi(gv[k])));
                    }
                    *(GAS u32x4*)orow0 = ov;
                }
            }
        }
        cur = nxt;
    }
    lds_barrier();
}

#define XB_TMO      128
#define XB_XCNT(j)  (256  + 64 * (j))
#define XB_XSUB(j)  (1280 + 64 * (j))
#define XB_XGEN(j)  (2304 + 64 * (j))
#define XB_TOP      3328
#define XB_TOPGEN   3392
#define XCD_BAR_WORDS 3456
#define XB_SPIN_CAP (1u << 18)

__device__ __forceinline__ unsigned xb_ld(unsigned* p)              { return __hip_atomic_load(p, __ATOMIC_RELAXED, __HIP_MEMORY_SCOPE_AGENT); }
__device__ __forceinline__ unsigned xb_add(unsigned* p, unsigned v) { return __hip_atomic_fetch_add(p, v, __ATOMIC_RELAXED, __HIP_MEMORY_SCOPE_AGENT); }
__device__ __forceinline__ unsigned xb_xcc_id() { return (unsigned)__builtin_amdgcn_s_getreg((3 << 11) | 20) & 0xFu; }
#define XB_SPIN(cond, bar) do { unsigned _sp = 0; while (cond) { __builtin_amdgcn_s_sleep(1); \
    if ((++_sp & 255u) == 0u) { if (xb_ld(&(bar)[XB_TMO])) break; if (_sp > XB_SPIN_CAP) { atomicAdd(&(bar)[XB_TMO], 1u); break; } } } } while (0)

struct XcdBarrier {
    unsigned* bar; unsigned x;
    volatile LAS unsigned* st;
};

__device__ __forceinline__ XcdBarrier xcd_barrier_post(unsigned* bar, volatile LAS unsigned* st) {
    XcdBarrier b; b.bar = bar; b.x = xb_xcc_id(); b.st = st;
    if (threadIdx.x == 0) (void)xb_add(&bar[XB_XCNT(b.x)], 1u);
    return b;
}
__device__ __forceinline__ void xcd_barrier_complete(unsigned* bar, unsigned x, unsigned& nloc, unsigned& nx) {
    const unsigned G = gridDim.x * gridDim.y * gridDim.z;
    unsigned sum, cnt, mine, sp = 0u;
    for (;;) {
        sum = 0u; cnt = 0u; mine = 0u;
#pragma unroll
        for (unsigned j = 0; j < 16; ++j) { const unsigned c = xb_ld(&bar[XB_XCNT(j)]); sum += c; cnt += (c > 0u) ? 1u : 0u; mine = (j == x) ? c : mine; }
        if (sum == G) break;
        __builtin_amdgcn_s_sleep(1);
        if ((++sp & 255u) == 0u) { if (xb_ld(&bar[XB_TMO])) break; if (sp > XB_SPIN_CAP) { atomicAdd(&bar[XB_TMO], 1u); break; } }
    }
    nloc = mine > 0u ? mine : 1u; nx = cnt > 0u ? cnt : 1u;
}

__device__ __forceinline__ void xcd_barrier(const XcdBarrier& b, bool leader) {
    asm volatile("s_waitcnt vmcnt(0)" ::: "memory");
    __syncthreads();
    if (leader) {
        unsigned* bar = b.bar;
        __builtin_amdgcn_s_waitcnt(0);
        unsigned nloc = b.st[0], nx = b.st[1];
        if (nloc == 0u) { xcd_barrier_complete(bar, b.x, nloc, nx); b.st[0] = nloc; b.st[1] = nx; }
        const unsigned old = xb_add(&bar[XB_XSUB(b.x)], 1u);
        const unsigned gen = old / nloc;
        if (old + 1u == (gen + 1u) * nloc) {
            __builtin_amdgcn_fence(__ATOMIC_RELEASE, "agent");
            asm volatile("s_waitcnt vmcnt(0)" ::: "memory");
            const unsigned og = xb_add(&bar[XB_TOP], 1u);
            const unsigned tg = og / nx;
            if (og + 1u == (tg + 1u) * nx) xb_add(&bar[XB_TOPGEN], 1u);
            else XB_SPIN(xb_ld(&bar[XB_TOPGEN]) == tg, bar);
            __builtin_amdgcn_fence(__ATOMIC_ACQUIRE, "agent");
            xb_add(&bar[XB_XGEN(b.x)], 1u);
            asm volatile("s_waitcnt vmcnt(0)" ::: "memory");
        } else {
            XB_SPIN(xb_ld(&bar[XB_XGEN(b.x)]) == gen, bar);
            __builtin_amdgcn_fence(__ATOMIC_ACQUIRE, "agent");
            asm volatile("s_waitcnt vmcnt(0)" ::: "memory");
        }
    }
    __syncthreads();
}


struct Params {
    const float *x, *mem, *norm_a, *w_in_a, *w_out_a, *norm_b, *w_in_b, *w_out_b, *w_mem_kv, *mem_norm_g, *kv_norm_g, *w_kv, *final_norm_g;
    float* out; unsigned char* ws; int ph_lo, ph_hi;
};
enum { K_PRO = 0, K_A_GEMM, K_A_STATE, K_A_RETOUT, K_A_OUT, K_KV, K_B_GEMM, K_B_ATTN, K_B_OUT, K_FINAL };
enum { T_NONE = 0, T_PRO, T_A0_STATE, T_A1_STATE, T_A1_OUT, T_KV, T_B0H1_ATTN, T_B1H0_GEMM };

struct TrJob { const float* W; int K, N, nsrc0, ncols; bf16_t* WT; int drow0; };
DI bool tr_job(const Params& p, unsigned char* ws, int tag, int j, TrJob& t) {
    bf16_t* Win = (bf16_t*)(ws + WS_WIN); bf16_t* Wout = (bf16_t*)(ws + WS_WOUT);
    if (tag == T_PRO) {
        if (j == 0) { t = TrJob{p.w_in_a, 2048, 8192, 0, 8192, Win, 0}; return true; }
        if (j == 1) { t = TrJob{p.w_out_a, 3072, 2048, 0, 2048, Wout, 0}; return true; }
        if (j < 6) { t = TrJob{p.w_mem_kv + (size_t)(j - 2) * 2048 * 2048, 2048, 2048, 0, 2048, (bf16_t*)(ws + WS_WMEMT), (j - 2) * 2048}; return true; }
        return false;
    }
    if (tag == T_A0_STATE) { if (j == 0) { t = TrJob{p.w_in_a + (size_t)2048 * 8192, 2048, 8192, 0, 8192, Win, 0}; return true; } return false; }
    if (tag == T_A1_OUT) { if (j == 0) { t = TrJob{p.w_kv, 2048, 12288, 0, 12288, (bf16_t*)(ws + WS_WKVT), 0}; return true; } return false; }
    if (tag == T_KV) { if (j == 0) { t = TrJob{p.w_out_b, 3072, 2048, 0, 2048, Wout, 0}; return true; } return false; }
    if (tag == T_B1H0_GEMM) { if (j == 0) { t = TrJob{p.w_out_b + (size_t)3072 * 2048, 3072, 2048, 0, 2048, Wout, 0}; return true; } return false; }
    if (tag == T_A1_STATE || tag == T_B0H1_ATTN) {
        const float* wi = p.w_in_b + (tag == T_A1_STATE ? 0 : (size_t)2048 * 10240);
        switch (j) {
            case 0: t = TrJob{wi, 2048, 10240, 0, 2048, Win, 0}; return true;
            case 1: t = TrJob{wi, 2048, 10240, 8192, 1024, Win, 3072}; return true;
            case 2: t = TrJob{wi, 2048, 10240, 9216, 1024, Win, 2048}; return true;
            case 3: t = TrJob{wi, 2048, 10240, 6144, 2048, Win, 4096}; return true;
            case 4: t = TrJob{wi, 2048, 10240, 2048, 2048, Win, 6144}; return true;
            case 5: t = TrJob{wi, 2048, 10240, 4096, 2048, Win, 8192}; return true;
            case 6: if (tag == T_A1_STATE) { t = TrJob{p.w_out_a + (size_t)3072 * 2048, 3072, 2048, 0, 2048, Wout, 0}; return true; } return false;
            default: return false;
        }
    }
    return false;
}
DI bool gemm_job(const Params& p, unsigned char* ws, int kind, int la, int lb, int hb, int j, int G, int bid, pg8::Gemm& g, pg8::EpiBf16& E, int& c) {
    c = bid;
    bf16_t* Win = (bf16_t*)(ws + WS_WIN); const float* SS = (const float*)(ws + WS_SS);
    if (kind == K_A_GEMM) {
        if (j == 0) { g = pg8::Gemm{(bf16_t*)(ws + WS_HA), Win, T_TOK, 8192, 2048, 2048, 1}; E = pg8::EpiBf16{(bf16_t*)(ws + WS_PROJA), 8192, 0, la == 0 ? nullptr : SS, 1}; return true; }
        if (j == 1 && la == 0) { g = pg8::Gemm{(bf16_t*)(ws + WS_MEMN), (bf16_t*)(ws + WS_WMEMT), 1024, 8192, 2048, 2048, 1}; E = pg8::EpiBf16{(bf16_t*)(ws + WS_MEMKV), 8192, 0, nullptr, 1}; c = (bid + G / 2) % G; return true; }
        return false;
    }
    if (kind == K_KV) {
        if (j >= 3) return false;
        const int dil = (j == 0) ? 1 : (j == 1 ? 4 : 16);
        g = pg8::Gemm{(bf16_t*)(ws + WS_HA), (bf16_t*)(ws + WS_WKVT) + (size_t)j * 4096 * 2048, T_TOK, 4096, 2048, 2048, dil};
        E = pg8::EpiBf16{(bf16_t*)(ws + WS_KV) + (size_t)j * T_TOK * 4096, 4096, 1, SS + T_TOK, dil}; return true;
    }
    if (kind == K_B_GEMM) {
        bf16_t* hB = (bf16_t*)(ws + WS_HB) + (size_t)hb * 8192 * DM; bf16_t* projB = (bf16_t*)(ws + WS_P);
        const float* ssb = SS + (size_t)(1 + lb) * T_TOK + (size_t)hb * 8192;
        if (j == 0) { g = pg8::Gemm{hB, Win, 8192, 6144, 2048, 2048, 1}; E = pg8::EpiBf16{projB, 10240, 0, ssb, 1}; return true; }
        if (j == 1) { g = pg8::Gemm{hB, Win + (size_t)6144 * 2048, 8192, 2048, 2048, 2048, 4}; E = pg8::EpiBf16{projB + 6144, 10240, 0, ssb, 4}; return true; }
        if (j == 2) { g = pg8::Gemm{hB, Win + (size_t)8192 * 2048, 8192, 2048, 2048, 2048, 16}; E = pg8::EpiBf16{projB + 8192, 10240, 0, ssb, 16}; return true; }
        return false;
    }
    return false;
}

__global__ void __launch_bounds__(NT, 2) yoco_fwd(Params p) {
    extern __shared__ __attribute__((aligned(16))) unsigned char lds_raw[];
    LAS unsigned char* lds = (LAS unsigned char*)lds_raw;
    const int bid = blockIdx.x;
    const int wave0 = __builtin_amdgcn_readfirstlane(threadIdx.x >> 6);
    volatile LAS unsigned* bst = (volatile LAS unsigned*)(lds + LDS_BYTES - 16);
    if (threadIdx.x < 2) bst[threadIdx.x] = 0u;
    __syncthreads();
    (void)xcd_barrier_post((unsigned*)(p.ws + WS_BAR), bst);
    unsigned long long t_prev = PROBE_TGROUP ? __builtin_amdgcn_s_memrealtime() : 0ull, t_acc = 0ull;
#pragma unroll 1
    for (int ph = p.ph_lo; ph < p.ph_hi; ++ph) {
        unsigned zz = 0u; asm volatile("" : "+s"(zz));
#define TIDX() const int tid = (wave0 << 6) | (int)__builtin_amdgcn_mbcnt_hi(~0u, __builtin_amdgcn_mbcnt_lo(~0u, zz)); __builtin_assume(tid >= 0 && tid < NT); const int lane = tid & 63, wave = wave0; const int gw = bid * 8 + wave; (void)lane; (void)wave; (void)gw
        int G = gridDim.x; asm volatile("" : "+s"(G));
        const int ngw = G * 8;
        unsigned char* ws_raw = p.ws; asm volatile("" : "+s"(ws_raw));
        unsigned char* ws = (unsigned char*)(__attribute__((address_space(1))) unsigned char*)ws_raw;
        int kind, la = 0, lb = 0, hb = 0;
        if (ph == 0) kind = K_PRO;
        else if (ph <= 8) { la = (ph - 1) / 4; kind = K_A_GEMM + (ph - 1) % 4; }
        else if (ph == 9) kind = K_KV;
        else if (ph <= 21) { const int idx = ph - 10; lb = idx / 6; hb = (idx / 3) % 2; kind = K_B_GEMM + idx % 3; }
        else kind = K_FINAL;
        int ttag = T_NONE, tngw = ngw; bool t_first = false;
        if (kind == K_PRO) { ttag = T_PRO; t_first = true; }
        else if (kind == K_A_RETOUT && la == 1) ttag = T_A1_STATE;
        else if (kind == K_A_OUT) ttag = (la == 0) ? T_A0_STATE : T_A1_OUT;
        else if (kind == K_KV) ttag = T_KV;
        else if (kind == K_B_ATTN && lb == 0 && hb == 1) ttag = T_B0H1_ATTN;
        else if (kind == K_B_GEMM && lb == 1 && hb == 0) ttag = T_B1H0_GEMM;

        if (kind == K_PRO) {
            TIDX();
            norm_rows(p.mem, p.mem_norm_g, (bf16_t*)(ws + WS_MEMN), 1024, gw, ngw, lane);
            float* cosT = (float*)(ws + WS_COS); float* sinT = (float*)(ws + WS_SIN); float* SSw = (float*)(ws + WS_SS);
            for (int i = bid * NT + tid; i < 4096 * 64; i += G * NT) { const int pos = i >> 6, j = i & 63;
                const float inv = 1.0f / powf(10000.0f, (float)j * (1.0f / 63.0f)); const float ang = (float)pos * inv;
                ((GAS float*)cosT)[i] = cosf(ang); ((GAS float*)sinT)[i] = sinf(ang); }
            for (int i = bid * NT + tid; i < 3 * T_TOK; i += G * NT) ((GAS float*)SSw)[i] = 0.f;
            norm_rows(p.x, p.norm_a, (bf16_t*)(ws + WS_HA), T_TOK, gw, ngw, lane);
        }
        if (kind == K_A_GEMM || kind == K_KV || kind == K_B_GEMM) {
            TIDX();
            pg8::Gemm g; pg8::EpiBf16 E; int c;
#pragma unroll 1
            for (int j = 0; gemm_job(p, ws, kind, la, lb, hb, j, G, bid, g, E, c); ++j) { pg8::StaticOrder S; S.init(g.M, g.N, G, c); pg8::gemm_phase(lds, g, S, E, tid); }
        }
        const bool t_early = (kind == K_A_OUT) && (bid & 1) && (ttag != T_NONE);
        if (t_early) {
            TIDX(); const int tgw = gw;
            LAS float* scr = (LAS float*)(lds + wave * 16640);
            TrJob t;
#pragma unroll 1
            for (int j = 0; tr_job(p, ws, ttag, j, t); ++j) transpose_seg(t.W, t.K, t.N, t.nsrc0, t.ncols, t.WT, t.drow0, scr, tgw, tngw, lane);
            __syncthreads();
        }
        if (kind == K_A_OUT || kind == K_B_OUT) {
            TIDX();
            pg8::Gemm g; pg8::EpiRes E; float* SSw = (float*)(ws + WS_SS);
            if (kind == K_A_OUT) {
                g = pg8::Gemm{(bf16_t*)(ws + WS_MIXA), (bf16_t*)(ws + WS_WOUT), T_TOK, 2048, 3072, 3072, 1};
                if (la == 0) E = pg8::EpiRes{p.x, p.out, p.norm_a + 2048, (bf16_t*)(ws + WS_HA), nullptr, nullptr, SSw};
                else E = pg8::EpiRes{p.out, p.out, p.kv_norm_g, (bf16_t*)(ws + WS_HA), p.norm_b, (bf16_t*)(ws + WS_HB), SSw + T_TOK};
            } else {
                float* xh = p.out + (size_t)hb * 8192 * DM;
                g = pg8::Gemm{(bf16_t*)(ws + WS_P), (bf16_t*)(ws + WS_WOUT), 8192, 2048, 3072, 10240, 1};
                if (lb == 0) E = pg8::EpiRes{xh, xh, p.norm_b + 2048, (bf16_t*)(ws + WS_HB) + (size_t)hb * 8192 * DM, nullptr, nullptr, SSw + 2 * T_TOK + (size_t)hb * 8192};
                else E = pg8::EpiRes{xh, xh, nullptr, nullptr, nullptr, nullptr, nullptr};
            }
            pg8::StaticOrder S; S.init(g.M, g.N, G, bid); pg8::gemm_phase(lds, g, S, E, tid);
        }
        if (kind == K_A_STATE) {
            TIDX();
#pragma unroll 1
            for (int it = bid; it < 128; it += G) { __syncthreads(); ret_state_item(lds, (bf16_t*)(ws + WS_PROJA), (bf16_t*)(ws + WS_RPREV), (float*)(ws + WS_COS), (float*)(ws + WS_SIN), it, tid); }
        }
        if (kind == K_B_ATTN) { TIDX(); dil_attn_phase(lds, ws, hb, 512, 1536, false, bid, G, tid); }
        if (kind == K_A_STATE || kind == K_B_ATTN) {
            TIDX();
            const bool isA = (kind == K_A_STATE);
            const int nit = 256;
            const int first = (isA && G >= 256) ? 128 : 0;
            const bf16_t* memKV = (bf16_t*)(ws + WS_MEMKV);
            if (bid >= first) {
#pragma unroll 1
                for (int it0 = bid - first; it0 < nit; it0 += G - first) {
                    const int it = isA ? it0 : (it0 >> 1); const int ehs = isA ? -1 : (it0 & 1);
                    const int mh = it & 3, blkr = it >> 2; const size_t row0 = (size_t)blkr * 256;
                    const int b = isA ? (blkr >> 4) : (hb * 2 + (blkr >> 4)); const int layer = isA ? la : 2 + lb;
                    const bf16_t* km = memKV + (size_t)b * 256 * 8192 + layer * 2048 + mh * 256;
                    const bf16_t* qp; const bf16_t* gp; bf16_t* op; size_t ldq, ldo;
                    if (isA) { const bf16_t* pa = (bf16_t*)(ws + WS_PROJA) + row0 * 8192; qp = pa + 6144 + mh * 256; gp = pa + 7168 + mh * 256; ldq = 8192; op = (bf16_t*)(ws + WS_MIXA) + row0 * 3072 + 2048 + mh * 256; ldo = 3072; }
                    else { bf16_t* pb = (bf16_t*)(ws + WS_P) + row0 * 10240; qp = pb + 3072 + mh * 256; gp = pb + 2048 + mh * 256; ldq = 10240; op = pb + 2048 + mh * 256; ldo = 10240; }
                    mem_attn_item(lds, qp, ldq, gp, ldq, op, ldo, km, km + 1024, tid, ehs);
                }
            }
        }
        if (kind == K_A_RETOUT) {
            TIDX();
#pragma unroll 1
            for (int it = bid; it < 1024; it += G) ret_out_item(lds, (bf16_t*)(ws + WS_PROJA), (bf16_t*)(ws + WS_RPREV), (bf16_t*)(ws + WS_MIXA), (float*)(ws + WS_COS), (float*)(ws + WS_SIN), it, tid);
        }
        if (kind == K_B_ATTN) {
            TIDX();
            { XcdBarrier xb; xb.bar = (unsigned*)(ws + WS_BAR); xb.x = xb_xcc_id(); xb.st = (volatile LAS unsigned*)(lds + LDS_BYTES - 16); xcd_barrier(xb, tid == 0); }
            dil_attn_phase(lds, ws, hb, 0, 512, true, bid, G, tid);
        }
        if (kind == K_FINAL) {
            TIDX();
#pragma unroll 1
            for (int m = gw; m < T_TOK; m += ngw) {
                float* xr = p.out + (size_t)m * DM;
                f32x4 v[8]; float s = 0.f;
#pragma unroll
                for (int j = 0; j < 8; ++j) { v[j] = ((const GAS f32x4*)xr)[lane + 64 * j]; s += (v[j].x * v[j].x + v[j].y * v[j].y) + (v[j].z * v[j].z + v[j].w * v[j].w); }
                const float rstd = rsqrtf(wave_sum(s, lane) * (1.f / DM) + EPS);
#pragma unroll
                for (int j = 0; j < 8; ++j) { const f32x4 gg = ((const GAS f32x4*)p.final_norm_g)[lane + 64 * j]; ((GAS f32x4*)xr)[lane + 64 * j] = v[j] * rstd * gg; }
            }
        }
        if (ttag != T_NONE && !t_early) {
            TIDX(); const int tgw = gw;
            __syncthreads();
            LAS float* scr = (LAS float*)(lds + wave * 16640);
            TrJob t;
#pragma unroll 1
            for (int j = 0; tr_job(p, ws, ttag, j, t); ++j) transpose_seg(t.W, t.K, t.N, t.nsrc0, t.ncols, t.WT, t.drow0, scr, tgw, tngw, lane);
        }
        if (ph + 1 < p.ph_hi) {
            if (ph == p.ph_lo) cg::this_grid().sync();
            else { TIDX(); XcdBarrier xb; xb.bar = (unsigned*)(ws + WS_BAR); xb.x = xb_xcc_id(); xb.st = (volatile LAS unsigned*)(lds + LDS_BYTES - 16); xcd_barrier(xb, tid == 0); }
        }
        if (PROBE_TGROUP) { const unsigned long long t_now = __builtin_amdgcn_s_memrealtime(); if ((PROBE_TGROUP >> kind) & 1) t_acc += t_now - t_prev; t_prev = t_now; }
    }
    if (PROBE_TGROUP && blockIdx.x == 0) { const unsigned long long t0 = __builtin_amdgcn_s_memrealtime(); while (__builtin_amdgcn_s_memrealtime() - t0 < 4ull * t_acc) __builtin_amdgcn_s_sleep(8); }
}

constexpr int N_PHASES = 1 + 2 * 4 + 1 + 4 * 3 + 1;

extern "C" void kernel_launch(void* const* d_in, const int* in_sizes, int n_in, void* d_out, int out_size, void* d_ws, size_t ws_size, hipStream_t stream) {
    static int grid = 0;
    if (grid == 0) {
        if (ws_size < WS_END) { fprintf(stderr, "kernel_launch: workspace too small: %zu < %zu\n", ws_size, (size_t)WS_END); grid = -1; return; }
        int dev = 0, cus = 0, per_cu = 0;
        hipGetDevice(&dev);
        hipDeviceGetAttribute(&cus, hipDeviceAttributeMultiprocessorCount, dev);
        if (hipFuncSetAttribute((const void*)yoco_fwd, hipFuncAttributeMaxDynamicSharedMemorySize, LDS_BYTES) != hipSuccess) { fprintf(stderr, "kernel_launch: hipFuncSetAttribute failed\n"); grid = -1; return; }
        if (hipOccupancyMaxActiveBlocksPerMultiprocessor(&per_cu, (const void*)yoco_fwd, NT, LDS_BYTES) != hipSuccess || per_cu < 1) { fprintf(stderr, "kernel_launch: occupancy query gave %d\n", per_cu); per_cu = 1; }
        (void)hipGetLastError();
        grid = cus;
        fprintf(stderr, "kernel_launch: grid %d (cus %d, per_cu %d), ws %zu\n", grid, cus, per_cu, ws_size);
    }
    if (grid < 0) return;
    (void)hipMemsetAsync((char*)d_ws + WS_BAR, 0, 16384, stream);
    Params p{};
    p.x = (const float*)d_in[0]; p.mem = (const float*)d_in[1]; p.norm_a = (const float*)d_in[2]; p.w_in_a = (const float*)d_in[3]; p.w_out_a = (const float*)d_in[4];
    p.norm_b = (const float*)d_in[5]; p.w_in_b = (const float*)d_in[6]; p.w_out_b = (const float*)d_in[7]; p.w_mem_kv = (const float*)d_in[8]; p.mem_norm_g = (const float*)d_in[9];
    p.kv_norm_g = (const float*)d_in[10]; p.w_kv = (const float*)d_in[11]; p.final_norm_g = (const float*)d_in[12];
    p.out = (float*)d_out; p.ws = (unsigned char*)d_ws;
#if MK_SPLIT
    for (int k = 0; k < N_PHASES; ++k) {
        p.ph_lo = k; p.ph_hi = k + 1;
        hipLaunchKernelGGL(yoco_fwd, dim3(grid), dim3(NT), LDS_BYTES, stream, p);
    }
#else
    p.ph_lo = 0; p.ph_hi = N_PHASES;
    void* args[] = {&p};
    hipError_t e = hipLaunchCooperativeKernel((const void*)yoco_fwd, dim3(grid), dim3(NT), args, LDS_BYTES, stream);
    if (e != hipSuccess) fprintf(stderr, "cooperative launch failed: %s (grid %d)\n", hipGetErrorString(e), grid);
#endif
}
```
